# Optimizing an MI355X kernel written in HIP

```python
import jax, jax.numpy as jnp
from jax import lax
import numpy as np

D_MODEL = 1024
BATCH = 2
SEQ = 8192
DEPTH = 2

GRID_W = 64
CTX_LEN = 256
N_MIXERS = 2
NORM_EPS = 1e-6

MLSTM_HEADS = 8
MLSTM_DV = D_MODEL // MLSTM_HEADS
MLSTM_DQK = MLSTM_DV // 2
MLSTM_QK_W = MLSTM_HEADS * MLSTM_DQK
MLSTM_V_W = MLSTM_HEADS * MLSTM_DV
MLSTM_O_W = MLSTM_V_W
MLSTM_GATE_W = 4 * MLSTM_HEADS
MLSTM_IN_W = 2 * MLSTM_QK_W + MLSTM_V_W + MLSTM_O_W + MLSTM_GATE_W
MLSTM_SPLITS = [MLSTM_QK_W, 2 * MLSTM_QK_W, 2 * MLSTM_QK_W + MLSTM_V_W, 2 * MLSTM_QK_W + MLSTM_V_W + MLSTM_O_W]
MLSTM_CHUNK = 64
GATE_SOFTCAP = 15.0

POOL_WINDOWS = (2, 4, 8, 16)
POOL_GROUPS = len(POOL_WINDOWS)
POOL_GW = D_MODEL // POOL_GROUPS

D_FF = 4 * D_MODEL

kernel_name = "hybrid_mlstm_pool_flow_backbone"


def rmsnorm(x, g):
    xf = x.astype(jnp.float32)
    y = xf * lax.rsqrt(jnp.mean(xf * xf, axis=-1, keepdims=True) + NORM_EPS)
    return (y * g.astype(jnp.float32)).astype(x.dtype)


def mlp(u, w1, w2):
    h = jnp.square(jax.nn.relu(u @ w1))
    return h @ w2


def mlstm_project(u, w_in, gate_b):
    bsz, L = u.shape[0], u.shape[1]
    p = u @ w_in
    q, k, v, o, g = jnp.split(p, MLSTM_SPLITS, axis=-1)

    def heads(t, d):
        return t.reshape(bsz, L, MLSTM_HEADS, d).transpose(0, 2, 1, 3).astype(jnp.float32)

    q = heads(q, MLSTM_DQK) * (MLSTM_DQK ** -0.5)
    k = heads(k, MLSTM_DQK)
    v = heads(v, MLSTM_DV)
    g = g.reshape(bsz, L, 4, MLSTM_HEADS).astype(jnp.float32) + gate_b.astype(jnp.float32)
    g = GATE_SOFTCAP * jnp.tanh(g / GATE_SOFTCAP)
    g = g.transpose(2, 0, 3, 1)
    log_i = g[0::2]
    log_f = jax.nn.log_sigmoid(g[1::2])
    return q, k, v, o, log_i, log_f


def mlstm_zero_state(bsz):
    return (jnp.zeros((bsz, MLSTM_HEADS, MLSTM_DV, MLSTM_DQK), jnp.float32),
            jnp.zeros((bsz, MLSTM_HEADS, MLSTM_DQK), jnp.float32),
            jnp.zeros((bsz, MLSTM_HEADS), jnp.float32))


def mlstm_state_update(state, k, v, log_i, log_f):
    C, n, m = state
    b = jnp.cumsum(log_f, axis=-1)
    b_end = b[..., -1]
    g = b_end[..., None] - b + log_i
    m_new = jnp.maximum(b_end + m, jnp.max(g, axis=-1))
    a = jnp.exp(b_end + m - m_new)
    w = jnp.exp(g - m_new[..., None])
    C = a[..., None, None] * C + jnp.einsum('bhsv,bhsd->bhvd', w[..., None] * v, k)
    n = a[..., None] * n + jnp.einsum('bhs,bhsd->bhd', w, k)
    return (C, n, m_new)


def mlstm_chunk(state, chunk):
    q, k, v, log_i, log_f = chunk
    C, n, m = state
    L = q.shape[-2]
    b = jnp.cumsum(log_f, axis=-1)
    order = jnp.tril(jnp.ones((L, L), dtype=bool))
    dmat = jnp.where(order, b[..., :, None] - b[..., None, :] + log_i[..., None, :], -jnp.inf)
    inter = b + m[..., None]
    m_t = jnp.maximum(inter, jnp.max(dmat, axis=-1))
    w_inter = jnp.exp(inter - m_t)
    s = jnp.einsum('bhtd,bhsd->bhts', q, k) * jnp.exp(dmat - m_t[..., None])
    num = w_inter[..., None] * jnp.einsum('bhvd,bhtd->bhtv', C, q) + jnp.einsum('bhts,bhsv->bhtv', s, v)
    den = w_inter * jnp.einsum('bhd,bhtd->bht', n, q) + jnp.sum(s, axis=-1)
    h = num / jnp.maximum(jnp.abs(den), jnp.exp(-m_t))[..., None]
    return mlstm_state_update(state, k, v, log_i, log_f), h


def mlstm_scan(state, q, k, v, log_i, log_f):
    bsz, nh, L = q.shape[0], q.shape[1], q.shape[2]
    nc = L // MLSTM_CHUNK

    def to_chunks(t):
        return jnp.moveaxis(t.reshape((bsz, nh, nc, MLSTM_CHUNK) + t.shape[3:]), 2, 0)

    final, h = lax.scan(mlstm_chunk, state, (to_chunks(q), to_chunks(k), to_chunks(v), to_chunks(log_i), to_chunks(log_f)))
    return jnp.moveaxis(h, 0, 2).reshape(bsz, nh, L, MLSTM_DV), final


def mlstm_output(h, o, norm_g, w_out):
    bsz, nh, L, dv = h.shape
    h = h * lax.rsqrt(jnp.mean(h * h, axis=-1, keepdims=True) + NORM_EPS)
    h = h.transpose(0, 2, 1, 3).reshape(bsz, L, nh * dv) * norm_g.astype(jnp.float32)
    y = (jax.nn.sigmoid(o.astype(jnp.float32)) * h).astype(o.dtype)
    return y @ w_out


def mlstm_mixer(xn, cn, w_in, gate_b, norm_g, w_out, ctx_out):
    qx, kx, vx, ox, lix, lfx = mlstm_project(xn, w_in, gate_b)
    qc, kc, vc, oc, lic, lfc = mlstm_project(cn, w_in, gate_b)
    hx = 0.0
    hc = 0.0
    for d in range(2):
        if d == 0:
            order = lambda t: t
        else:
            order = lambda t: jnp.flip(t, axis=2)
        zero = mlstm_zero_state(kc.shape[0])
        c_k, c_v, c_li, c_lf = order(kc), order(vc), order(lic[d]), order(lfc[d])
        if ctx_out:
            h_c, state = mlstm_scan(zero, order(qc), c_k, c_v, c_li, c_lf)
            hc = hc + order(h_c)
        else:
            state = mlstm_state_update(zero, c_k, c_v, c_li, c_lf)
        h_x, _ = mlstm_scan(state, order(qx), order(kx), order(vx), order(lix[d]), order(lfx[d]))
        hx = hx + order(h_x)
    y = mlstm_output(hx, ox, norm_g, w_out)
    y_ctx = mlstm_output(hc, oc, norm_g, w_out) if ctx_out else None
    return y, y_ctx


def centred_mean(u, window):
    L = u.shape[-2]
    cs = jnp.cumsum(u, axis=-2)
    cs = jnp.concatenate([jnp.zeros_like(cs[..., :1, :]), cs], axis=-2)
    t = jnp.arange(L)
    lo = jnp.clip(t - window // 2, 0, L)
    hi = jnp.clip(t - window // 2 + window, 0, L)
    total = jnp.take(cs, hi, axis=-2) - jnp.take(cs, lo, axis=-2)
    return total / (hi - lo).astype(u.dtype)[:, None]


def pool_mixer(u, w, scale):
    uf = u.astype(jnp.float32)
    pooled = jnp.stack([centred_mean(uf[..., gi * POOL_GW:(gi + 1) * POOL_GW], win)
                        for gi, win in enumerate(POOL_WINDOWS)], axis=-2)
    p = pooled - uf.reshape(uf.shape[:-1] + (POOL_GROUPS, POOL_GW))
    y = jnp.einsum('...gc,gcd->...gd', p.astype(u.dtype), w)
    return y.reshape(u.shape) * scale


def setup_inputs(seed: int = 0) -> dict:
    key = jax.random.key(seed)
    ks = jax.random.split(key, 18)
    D = D_MODEL
    n_a = (DEPTH + 1) // N_MIXERS
    n_b = DEPTH // N_MIXERS

    def nrm(k, shape, s):
        return jax.random.normal(k, shape, jnp.float32) * s

    f_bias = jnp.linspace(3.0, 6.0, MLSTM_HEADS, dtype=jnp.float32)
    zeros_h = jnp.zeros((MLSTM_HEADS,), jnp.float32)
    gate_base = jnp.stack([zeros_h, f_bias, zeros_h, f_bias])
    return {
        "x": nrm(ks[0], (BATCH, SEQ, D), 1.0),
        "c": nrm(ks[1], (BATCH, D), 1.0),
        "ctx": nrm(ks[2], (BATCH, CTX_LEN, D), 1.0),
        "c_ctx": nrm(ks[3], (D,), 1.0),
        "ada_w": nrm(ks[4], (DEPTH, D, 6 * D), 0.5 * D ** -0.5),
        "ada_b": nrm(ks[5], (DEPTH, 6 * D), 0.02),
        "norm1_g": 1.0 + nrm(ks[6], (DEPTH, D), 0.02),
        "norm2_g": 1.0 + nrm(ks[7], (DEPTH, D), 0.02),
        "mlstm_w_in": nrm(ks[8], (n_a, D, MLSTM_IN_W), D ** -0.5),
        "mlstm_gate_b": gate_base + nrm(ks[9], (n_a, 4, MLSTM_HEADS), 0.1),
        "mlstm_norm_g": 1.0 + nrm(ks[10], (n_a, MLSTM_V_W), 0.02),
        "mlstm_w_out": nrm(ks[11], (n_a, MLSTM_V_W, D), MLSTM_V_W ** -0.5),
        "pool_w": nrm(ks[12], (n_b, POOL_GROUPS, POOL_GW, POOL_GW), POOL_GW ** -0.5),
        "pool_scale": 1.0 + nrm(ks[13], (n_b, D), 0.02),
        "mlp_w1": nrm(ks[14], (DEPTH, D, D_FF), D ** -0.5),
        "mlp_w2": nrm(ks[15], (DEPTH, D_FF, D), D_FF ** -0.5),
        "final_g": 1.0 + nrm(ks[16], (D,), 0.02),
    }


def reference(x, c, ctx, c_ctx, ada_w, ada_b, norm1_g, norm2_g, mlstm_w_in, mlstm_gate_b,
              mlstm_norm_g, mlstm_w_out, pool_w, pool_scale, mlp_w1, mlp_w2, final_g):
    bsz, seq, dm = x.shape
    rows = seq // GRID_W
    silu_c = jax.nn.silu(c)
    silu_cc = jax.nn.silu(c_ctx)
    for i in range(DEPTH):
        kind = i % N_MIXERS
        j = i // N_MIXERS
        ctx_next = any(l % N_MIXERS == 0 for l in range(i + 1, DEPTH))
        mod = (silu_c @ ada_w[i] + ada_b[i])[:, None, :]
        sh1, sc1, g1, sh2, sc2, g2 = jnp.split(mod, 6, axis=-1)
        xn = rmsnorm(x, norm1_g[i]) * (1 + sc1) + sh1
        if kind == 0 or ctx_next:
            cmod = silu_cc @ ada_w[i] + ada_b[i]
            csh1, csc1, cg1, csh2, csc2, cg2 = jnp.split(cmod, 6)
            cn = rmsnorm(ctx, norm1_g[i]) * (1 + csc1) + csh1
        if kind == 0:
            y, y_ctx = mlstm_mixer(xn, cn, mlstm_w_in[j], mlstm_gate_b[j], mlstm_norm_g[j], mlstm_w_out[j], ctx_next)
        else:
            y = pool_mixer(xn.reshape(bsz, rows, GRID_W, dm), pool_w[j], pool_scale[j]).reshape(bsz, seq, dm)
            y_ctx = pool_mixer(cn, pool_w[j], pool_scale[j]) if ctx_next else None
        x = x + g1 * y
        x = x + g2 * mlp(rmsnorm(x, norm2_g[i]) * (1 + sc2) + sh2, mlp_w1[i], mlp_w2[i])
        if ctx_next:
            ctx = ctx + cg1 * y_ctx
            ctx = ctx + cg2 * mlp(rmsnorm(ctx, norm2_g[i]) * (1 + csc2) + csh2, mlp_w1[i], mlp_w2[i])
    return rmsnorm(x, final_g)
```

```cpp
#include <hip/hip_runtime.h>
#include <hip/hip_cooperative_groups.h>
#include <cstdio>
#include <cstdint>
namespace cg = cooperative_groups;

#define LAS __attribute__((address_space(3)))
typedef unsigned short bf16_t;
typedef short bf16x8 __attribute__((ext_vector_type(8)));
typedef short bf16x4 __attribute__((ext_vector_type(4)));
typedef float f32x4 __attribute__((ext_vector_type(4)));
typedef float f32x2 __attribute__((ext_vector_type(2)));
typedef unsigned u32x4 __attribute__((ext_vector_type(4)));
typedef unsigned u32x2 __attribute__((ext_vector_type(2)));

constexpr int D = 1024, SEQ = 8192, MROWS = 16384, CTXL = 256, MALL = MROWS + 2 * CTXL;
constexpr int NH = 8, DQK = 64, DV = 128, FF = 4096, NIN = 3104, NIN_PAD = 3328;
constexpr int NPOS = 132;
constexpr float EPS = 1e-6f;

constexpr size_t MiB = 1u << 20;
constexpr size_t WS_BAR = 0;
constexpr size_t WS_PCNT = 16384;
constexpr size_t CTL_BYTES = 16384 + 4 * 16384;
constexpr size_t WS_XCH = 248 * MiB;
constexpr size_t WS_RST = 249 * MiB;
constexpr size_t WS_MOD = 98304;
constexpr size_t WS_GS = 512 * 1024;
constexpr size_t WS_WIN = 1 * MiB;
constexpr size_t WS_WOUT = 8 * MiB;
constexpr size_t WS_W1 = 10 * MiB;
constexpr size_t WS_W2 = 26 * MiB;
constexpr size_t WS_POOL = 42 * MiB;
constexpr size_t WS_POOLG = 43 * MiB;
constexpr size_t WS_XN = 44 * MiB;
constexpr size_t WS_Q = 78 * MiB;
constexpr size_t WS_K = 94 * MiB;
constexpr size_t WS_V = 111 * MiB;
constexpr size_t WS_SO = 144 * MiB;
constexpr size_t WS_G = 176 * MiB;
constexpr size_t WS_DC = 179 * MiB;
constexpr size_t WS_DN = 245 * MiB;
constexpr size_t WS_BG = 247 * MiB;
constexpr size_t WS_MS = 247 * MiB + 65536;
constexpr size_t WS_H = 78 * MiB;
constexpr int LDS_BYTES = 147456;

struct Params {
    const float *x, *c, *ctx, *c_ctx, *ada_w, *ada_b, *norm1_g, *norm2_g, *w_in, *gate_b, *mnorm_g, *w_out, *pool_w, *pool_scale, *w1, *w2, *final_g;
    float* out; unsigned char* ws;
};

typedef __bf16 bf16v2_t __attribute__((ext_vector_type(2)));
__device__ __forceinline__ unsigned cvt_pk_bf16(float lo, float hi) { const f32x2 v = {lo, hi}; const bf16v2_t r = __builtin_convertvector(v, bf16v2_t); return __builtin_bit_cast(unsigned, r); }
__device__ __forceinline__ float bf_lo(unsigned u) { return __uint_as_float(u << 16); }
__device__ __forceinline__ float bf_hi(unsigned u) { return __uint_as_float(u & 0xffff0000u); }
__device__ __forceinline__ float bf2f(unsigned short b) { return __uint_as_float(((unsigned)b) << 16); }
__device__ __forceinline__ unsigned short f2bf(float f) { return (unsigned short)(cvt_pk_bf16(f, 0.f) & 0xffffu); }
__device__ __forceinline__ float wave_sum(float v) {
#pragma unroll
    for (int o = 1; o < 64; o <<= 1) v += __shfl_xor(v, o);
    return v;
}
__device__ __forceinline__ float wave_max(float v) {
#pragma unroll
    for (int o = 1; o < 64; o <<= 1) v = fmaxf(v, __shfl_xor(v, o));
    return v;
}
__device__ __forceinline__ float wave_incl_sum(float v, int lane) {
#pragma unroll
    for (int o = 1; o < 64; o <<= 1) { const float t = __shfl_up(v, o); if (lane >= o) v += t; }
    return v;
}
__device__ __forceinline__ float wave_incl_max(float v, int lane) {
#pragma unroll
    for (int o = 1; o < 64; o <<= 1) { const float t = __shfl_up(v, o); if (lane >= o) v = fmaxf(v, t); }
    return v;
}
#define NTL(p) __builtin_nontemporal_load(p)
#define NTS(v, p) __builtin_nontemporal_store(v, p)
__device__ __forceinline__ float sigmoidf_(float x) { return __builtin_amdgcn_rcpf(1.f + __expf(-x)); }
__device__ __forceinline__ float log_sigmoid(float x) { return fminf(x, 0.f) - log1pf(expf(-fabsf(x))); }

namespace pg8 {
constexpr int BM = 256, BK = 64, HALF = 128, HTB = HALF * BK * 2, STAGE_BYTES = 8 * HTB, NXCD = 8, WGM = 2;
__host__ __device__ __forceinline__ int lds_byte(int r, int c) { const int st = (r >> 4) * 2 + (c >> 5), rr = r & 15, cc = c & 31, ob = rr * 64 + cc * 2; return st * 1024 + (ob ^ (((ob >> 9) & 1) << 5)); }
__host__ __device__ __forceinline__ void stage_rc(int b, int& R, int& C) { const int st = b / 1024, sb = b % 1024, swz = sb ^ (((sb >> 9) & 1) << 5); R = (st >> 1) * 16 + swz / 64; C = (st & 1) * 32 + (swz % 64) / 2; }
__host__ __device__ __forceinline__ int perm32(int rho) { const int n = rho >> 4, i = rho & 15; return 8 * (i >> 2) + 4 * n + (i & 3); }

struct Unit { int pm, pn; };
struct Gemm { const bf16_t* A; const bf16_t* Bt; };

struct StaticOrder {
    int nM, nN, nwg, G, c;
    __device__ void init(int M, int N, int G_, int c_) { nM = M / BM; nN = N / BM; nwg = nM * nN; G = G_; c = c_; }
    __device__ bool next(int i, Unit& u) const {
        const long L = (long)i * G + c; if (L >= nwg) return false;
        int wgid = (int)L; { const int q = nwg / NXCD, r = nwg % NXCD, xcd = wgid % NXCD, off = wgid / NXCD; wgid = (xcd < r ? xcd * (q + 1) : r * (q + 1) + (xcd - r) * q) + off; }
        const int nig = WGM * nN, gid = wgid / nig, fm = gid * WGM, gsz = (nM - fm) < WGM ? (nM - fm) : WGM;
        u.pm = fm + ((wgid % nig) % gsz); u.pn = (wgid % nig) / gsz; return true;
    }
};
struct InOrder {
    int G, c; StaticOrder S;
    __device__ void init(int G_, int c_) { G = G_; c = c_; S.init(MROWS, 3072, G_, c_); }
    __device__ bool next(int i, Unit& u) const {
        const int L = i * G + c;
        if (L < 768) return S.next(i, u);
        return false;
    }
};

template <class Epi, class Sched, bool ALIGN_EPI, int LDA, int LDB, int KK, int ACOL>
__device__ __forceinline__ void gemm_phase(LAS unsigned char* lds, const Gemm g, const Sched& S, const Epi& E) {
    int tid = threadIdx.x; asm volatile("" : "+v"(tid));
    const int wid = __builtin_amdgcn_readfirstlane(tid >> 6), lane = tid & 63, wr = wid >> 2, wc = wid & 3, fr = lane & 15, fq = lane >> 4;
    constexpr int nt = KK / BK;
    unsigned voffA[2], voffB[2];
#pragma unroll
    for (int i = 0; i < 2; ++i) { int R, C; stage_rc(tid * 16 + i * 8192, R, C); const int Rb = Epi::PERM ? ((R & ~31) + perm32(R & 31)) : R;
        voffA[i] = (unsigned)(R * LDA + C) * 2u; voffB[i] = (unsigned)(Rb * LDB + C) * 2u; }
    constexpr size_t kstep = (size_t)(BK * 2);
    constexpr size_t hstepA = (size_t)HALF * LDA * 2, hstepB = (size_t)HALF * LDB * 2;
    constexpr size_t tstepA = 2 * hstepA, tstepB = 2 * hstepB;
    const unsigned ldsw = (unsigned)wid * 1024u;
    const int aoff = lds_byte(wr * 64 + fr, fq * 8), boff = lds_byte(wc * 32 + fr, fq * 8);
#define PG8_SA(b, h) (((b) * 2 + (h)) * HTB)
#define PG8_SB(b, h) ((4 + (b) * 2 + (h)) * HTB)
#define PG8_STAGE(bufoff, gbase, voff) do { _Pragma("unroll") for (int _i = 0; _i < 2; ++_i) \
        __builtin_amdgcn_global_load_lds((const unsigned*)((const char*)(gbase) + (voff)[_i]), (LAS unsigned*)(lds + (bufoff) + ldsw + _i * 8192), 16, 0, 0); } while (0)
#define PG8_LDA(dst, b, h) do { _Pragma("unroll") for (int m = 0; m < 4; ++m) _Pragma("unroll") for (int k = 0; k < 2; ++k) dst[m][k] = *(const LAS bf16x8*)(lds + PG8_SA(b, h) + aoff + m * 2048 + k * 1024); } while (0)
#define PG8_LDB(dst, b, h) do { _Pragma("unroll") for (int n = 0; n < 2; ++n) _Pragma("unroll") for (int k = 0; k < 2; ++k) dst[n][k] = *(const LAS bf16x8*)(lds + PG8_SB(b, h) + boff + n * 2048 + k * 1024); } while (0)
#define PG8_MMA(ai, bj, At, Bt) do { __builtin_amdgcn_s_setprio(1); _Pragma("unroll") for (int m = 0; m < 4; ++m) _Pragma("unroll") for (int n = 0; n < 2; ++n) _Pragma("unroll") for (int k = 0; k < 2; ++k) \
        acc[ai][bj][m][n] = __builtin_amdgcn_mfma_f32_16x16x32_bf16(Bt[n][k], At[m][k], acc[ai][bj][m][n], 0, 0, 0); __builtin_amdgcn_s_setprio(0); } while (0)
#define PG8_WAIT_V(n) asm volatile("s_waitcnt vmcnt(" #n ")" ::: "memory")
#define PG8_WAIT_L(n) asm volatile("s_waitcnt lgkmcnt(" #n ")" ::: "memory")
#define PG8_BAR __builtin_amdgcn_s_barrier()
#define PG8_SCHED __builtin_amdgcn_sched_barrier(0)
    Unit cur, nxt; int ui = 0;
    if (!S.next(0, cur)) return;
    f32x4 acc[2][2][4][2];
#pragma unroll
    for (int a = 0; a < 2; ++a)
#pragma unroll
        for (int b = 0; b < 2; ++b)
#pragma unroll
            for (int m = 0; m < 4; ++m)
#pragma unroll
                for (int n = 0; n < 2; ++n) acc[a][b][m][n] = (f32x4){0.f, 0.f, 0.f, 0.f};
    bf16x8 At[4][2], B0[2][2], B1[2][2];
    const char* cA = (const char*)g.A + (size_t)cur.pm * tstepA + (size_t)cur.pn * ACOL * 2; const char* cB = (const char*)g.Bt + (size_t)cur.pn * tstepB;
    PG8_STAGE(PG8_SB(0, 0), cB, voffB); PG8_STAGE(PG8_SB(0, 1), cB + hstepB, voffB); PG8_STAGE(PG8_SA(0, 0), cA, voffA); PG8_STAGE(PG8_SA(0, 1), cA + hstepA, voffA);
    if (wr == 1) PG8_BAR;
    PG8_WAIT_V(2); PG8_BAR;
    PG8_STAGE(PG8_SB(1, 0), cB + kstep, voffB); PG8_STAGE(PG8_SA(1, 0), cA + kstep, voffA); PG8_STAGE(PG8_SB(1, 1), cB + hstepB + kstep, voffB);
    PG8_WAIT_V(6); PG8_BAR;
    for (;;) {
        const bool has_next = S.next(ui + 1, nxt);
        const char* nA = has_next ? (const char*)g.A + (size_t)nxt.pm * tstepA + (size_t)nxt.pn * ACOL * 2 : cA; const char* nB = has_next ? (const char*)g.Bt + (size_t)nxt.pn * tstepB : cB;
        for (int t = 0; t < nt; t += 2) {
            const bool last = (t == nt - 2);
            const char* a1 = cA + (size_t)(t + 1) * kstep;
            const char* a2 = last ? nA : cA + (size_t)(t + 2) * kstep; const char* b2 = last ? nB : cB + (size_t)(t + 2) * kstep;
            const char* a3 = a2 + kstep; const char* b3 = b2 + kstep;
            PG8_LDB(B0, 0, 0); PG8_LDB(B1, 0, 1); PG8_SCHED; PG8_LDA(At, 0, 0); PG8_STAGE(PG8_SA(1, 1), a1 + hstepA, voffA);
            PG8_WAIT_V(8); PG8_WAIT_L(0); PG8_BAR; PG8_MMA(0, 0, At, B0); PG8_MMA(0, 1, At, B1); PG8_BAR; PG8_SCHED;
            PG8_LDA(At, 0, 1); PG8_STAGE(PG8_SB(0, 0), b2, voffB); PG8_STAGE(PG8_SB(0, 1), b2 + hstepB, voffB); PG8_STAGE(PG8_SA(0, 0), a2, voffA);
            PG8_WAIT_V(8); PG8_WAIT_L(0); PG8_BAR; PG8_MMA(1, 0, At, B0); PG8_MMA(1, 1, At, B1); PG8_BAR; PG8_SCHED;
            PG8_LDB(B0, 1, 0); PG8_LDB(B1, 1, 1); PG8_SCHED; PG8_LDA(At, 1, 0); PG8_STAGE(PG8_SA(0, 1), a2 + hstepA, voffA);
            PG8_WAIT_V(8); PG8_WAIT_L(0); PG8_BAR; PG8_MMA(0, 0, At, B0); PG8_MMA(0, 1, At, B1); PG8_BAR; PG8_SCHED;
            PG8_LDA(At, 1, 1); PG8_STAGE(PG8_SB(1, 0), b3, voffB); PG8_STAGE(PG8_SB(1, 1), b3 + hstepB, voffB); PG8_STAGE(PG8_SA(1, 0), a3, voffA);
            PG8_WAIT_V(8); PG8_WAIT_L(0); PG8_BAR; PG8_MMA(1, 0, At, B0); PG8_MMA(1, 1, At, B1); PG8_BAR; PG8_SCHED;
        }
        if constexpr (ALIGN_EPI) { if (wr == 0) PG8_BAR; }
        if (!Epi::DRAIN_LAST || has_next) E(acc, cur, wr, wc, fr, fq);
        if (!has_next) break;
#pragma unroll
        for (int a = 0; a < 2; ++a)
#pragma unroll
            for (int b = 0; b < 2; ++b)
#pragma unroll
                for (int m = 0; m < 4; ++m)
#pragma unroll
                    for (int n = 0; n < 2; ++n) acc[a][b][m][n] = (f32x4){0.f, 0.f, 0.f, 0.f};
        cur = nxt; cA = nA; cB = nB; ++ui;
        if constexpr (ALIGN_EPI) { if (wr == 1) PG8_BAR; }
    }
    PG8_WAIT_V(0);
    if constexpr (!ALIGN_EPI) { if (wr == 0) PG8_BAR; }
    PG8_BAR;
    if constexpr (Epi::DRAIN_LAST) E.drained(acc, cur, wr, wc, fr, fq, lds, wid, lane);
#undef PG8_SA
#undef PG8_SB
#undef PG8_STAGE
#undef PG8_LDA
#undef PG8_LDB
#undef PG8_MMA
#undef PG8_WAIT_V
#undef PG8_WAIT_L
#undef PG8_BAR
#undef PG8_SCHED
}

struct EpiIn {
    static constexpr bool PERM = true, DRAIN_LAST = false;
    bf16_t *Q, *Kb, *V, *SO; float* G; const float* gate_b;
    __device__ __forceinline__ void operator()(const f32x4 (&acc)[2][2][4][2], const Unit& u, int wr, int wc, int fr, int fq) const {
        const int row0 = u.pm * BM + wr * 64 + fr; const int pn = u.pn;
        if (pn == 12) {
            if (wc == 0) {
#pragma unroll
                for (int n = 0; n < 2; ++n) {
                    const int c0 = 8 * fq + 4 * n; const f32x4 gb = *(const f32x4*)(gate_b + c0);
#pragma unroll
                    for (int ai = 0; ai < 2; ++ai)
#pragma unroll
                        for (int m = 0; m < 4; ++m) {
                            f32x4 v = acc[ai][0][m][n] + gb;
#pragma unroll
                            for (int j = 0; j < 4; ++j) { float t = 15.f * tanhf(v[j] * (1.f / 15.f)); if (fq & 1) t = log_sigmoid(t); v[j] = t; }
                            *(f32x4*)(G + (size_t)(row0 + ai * HALF + m * 16) * 32 + c0) = v;
                        }
                }
            }
            return;
        }
        bf16_t* base; int ldc, colt; float sc = 1.f; bool sg = false;
        if (pn < 2) { base = Q; ldc = 512; colt = pn * 256; sc = 0.125f; }
        else if (pn < 4) { base = Kb; ldc = 512; colt = (pn - 2) * 256; }
        else if (pn < 8) { base = V; ldc = 1024; colt = (pn - 4) * 256; }
        else { base = SO; ldc = 1024; colt = (pn - 8) * 256; sg = true; }
        const int col0 = colt + wc * 32 + 8 * fq;
#pragma unroll
        for (int ai = 0; ai < 2; ++ai)
#pragma unroll
            for (int m = 0; m < 4; ++m) { bf16_t* rowp = base + (size_t)(row0 + ai * HALF + m * 16) * ldc + col0;
#pragma unroll
                for (int bj = 0; bj < 2; ++bj) { f32x4 v0 = acc[ai][bj][m][0], v1 = acc[ai][bj][m][1];
                    if (sg) {
#pragma unroll
                        for (int j = 0; j < 4; ++j) { v0[j] = sigmoidf_(v0[j]); v1[j] = sigmoidf_(v1[j]); }
                    } else { v0 = v0 * sc; v1 = v1 * sc; }
                    u32x4 w; w.x = cvt_pk_bf16(v0[0], v0[1]); w.y = cvt_pk_bf16(v0[2], v0[3]); w.z = cvt_pk_bf16(v1[0], v1[1]); w.w = cvt_pk_bf16(v1[2], v1[3]);
                    *(u32x4*)(rowp + bj * HALF) = w; } }
    }
};
struct EpiRelu2 {
    static constexpr bool PERM = true, DRAIN_LAST = false;
    bf16_t* H;
    __device__ __forceinline__ void operator()(const f32x4 (&acc)[2][2][4][2], const Unit& u, int wr, int wc, int fr, int fq) const {
        const int row0 = u.pm * BM + wr * 64 + fr, col0 = u.pn * BM + wc * 32 + 8 * fq;
#pragma unroll
        for (int ai = 0; ai < 2; ++ai)
#pragma unroll
            for (int m = 0; m < 4; ++m) { bf16_t* rowp = H + (size_t)(row0 + ai * HALF + m * 16) * FF + col0;
#pragma unroll
                for (int bj = 0; bj < 2; ++bj) { f32x4 v0 = acc[ai][bj][m][0], v1 = acc[ai][bj][m][1];
#pragma unroll
                    for (int j = 0; j < 4; ++j) { const float a = fmaxf(v0[j], 0.f), b = fmaxf(v1[j], 0.f); v0[j] = a * a; v1[j] = b * b; }
                    u32x4 w; w.x = cvt_pk_bf16(v0[0], v0[1]); w.y = cvt_pk_bf16(v0[2], v0[3]); w.z = cvt_pk_bf16(v1[0], v1[1]); w.w = cvt_pk_bf16(v1[2], v1[3]);
                    *(u32x4*)(rowp + bj * HALF) = w; } }
    }
};
struct EpiRes {
    static constexpr bool PERM = false, DRAIN_LAST = true;
    const float* base; float* out; const float* gate; int gstride;
    __device__ __forceinline__ void operator()(const f32x4 (&acc)[2][2][4][2], const Unit& u, int wr, int wc, int fr, int fq) const {
        const int row0 = u.pm * BM + wr * 64 + fr, col0 = u.pn * BM + wc * 32 + 4 * fq;
        const float* gp = gate + (size_t)(u.pm >> 5) * gstride + col0;
        f32x4 gv[2][2];
#pragma unroll
        for (int bj = 0; bj < 2; ++bj)
#pragma unroll
            for (int n = 0; n < 2; ++n) { gv[bj][n] = *(const f32x4*)(gp + bj * HALF + n * 16); }
#pragma unroll
        for (int ai = 0; ai < 2; ++ai)
#pragma unroll
            for (int m = 0; m < 4; ++m) { const size_t off = (size_t)(row0 + ai * HALF + m * 16) * D + col0;
#pragma unroll
                for (int bj = 0; bj < 2; ++bj)
#pragma unroll
                    for (int n = 0; n < 2; ++n) { const f32x4 bs = *(const f32x4*)(base + off + bj * HALF + n * 16); *(f32x4*)(out + off + bj * HALF + n * 16) = bs + gv[bj][n] * acc[ai][bj][m][n]; }
                asm volatile("" ::: "memory"); }
    }
    __device__ __forceinline__ void drained(const f32x4 (&acc)[2][2][4][2], const Unit& u, int wr, int wc, int fr, int fq, LAS unsigned char* lds, int wid, int lane) const {
        const int row0 = u.pm * BM + wr * 64 + fr, col0 = u.pn * BM + wc * 32 + 4 * fq;
        const float* gp = gate + (size_t)(u.pm >> 5) * gstride + col0;
        f32x4 gv[2][2];
#pragma unroll
        for (int bj = 0; bj < 2; ++bj)
#pragma unroll
            for (int n = 0; n < 2; ++n) gv[bj][n] = *(const f32x4*)(gp + bj * HALF + n * 16);
        LAS unsigned char* wb = lds + wid * 16384;
#pragma unroll
        for (int ai = 0; ai < 2; ++ai) {
#pragma unroll
            for (int m = 0; m < 4; ++m)
#pragma unroll
                for (int bj = 0; bj < 2; ++bj)
#pragma unroll
                    for (int n = 0; n < 2; ++n) { const size_t off = (size_t)(row0 + ai * HALF + m * 16) * D + col0 + bj * HALF + n * 16;
                        __builtin_amdgcn_global_load_lds((const unsigned*)(base + off), (LAS unsigned*)(wb + (m * 4 + bj * 2 + n) * 1024), 16, 0, 0); }
            asm volatile("s_waitcnt vmcnt(0)" ::: "memory");
#pragma unroll
            for (int m = 0; m < 4; ++m)
#pragma unroll
                for (int bj = 0; bj < 2; ++bj)
#pragma unroll
                    for (int n = 0; n < 2; ++n) { const size_t off = (size_t)(row0 + ai * HALF + m * 16) * D + col0 + bj * HALF + n * 16;
                        const f32x4 bs = *(const LAS f32x4*)(wb + (m * 4 + bj * 2 + n) * 1024 + lane * 16);
                        *(f32x4*)(out + off) = bs + gv[bj][n] * acc[ai][bj][m][n]; }
            asm volatile("s_waitcnt lgkmcnt(0)" ::: "memory");
        }
    }
};
template <int MODE> struct EpiNorm {
    static constexpr bool PERM = false, DRAIN_LAST = true;
    const float* base; float* out; const float* gate; int gstride; float* xch; unsigned* pcnt; const float* va; const float* sc; const float* sh; int mstride; bf16_t* XN; float* rst;
    __device__ __forceinline__ void operator()(const f32x4 (&acc)[2][2][4][2], const Unit& u, int wr, int wc, int fr, int fq) const {}
    __device__ __forceinline__ void drained(f32x4 (&acc)[2][2][4][2], const Unit& u, int wr, int wc, int fr, int fq, LAS unsigned char* lds, int wid, int lane) const {
        const int row0 = u.pm * BM + wr * 64 + fr, col0 = u.pn * BM + wc * 32 + 4 * fq;
        const float* gp = gate + (size_t)(u.pm >> 5) * gstride + col0;
        LAS float* P = (LAS float*)(lds + 131072); LAS float* S = (LAS float*)(lds + 131072 + 4096);
        {
            f32x4 gv[2][2];
#pragma unroll
            for (int bj = 0; bj < 2; ++bj)
#pragma unroll
                for (int n = 0; n < 2; ++n) gv[bj][n] = *(const f32x4*)(gp + bj * HALF + n * 16);
#pragma unroll
            for (int ai = 0; ai < 2; ++ai)
#pragma unroll
                for (int m = 0; m < 4; ++m) { const size_t off = (size_t)(row0 + ai * HALF + m * 16) * D + col0; float ss = 0.f;
#pragma unroll
                    for (int bj = 0; bj < 2; ++bj)
#pragma unroll
                        for (int n = 0; n < 2; ++n) { const f32x4 bs = NTL((const f32x4*)(base + off + bj * HALF + n * 16)); const f32x4 o = bs + gv[bj][n] * acc[ai][bj][m][n]; acc[ai][bj][m][n] = o;
                            if (MODE != 0) NTS(o, (f32x4*)(out + off + bj * HALF + n * 16));
                            ss += (o[0] * o[0] + o[1] * o[1]) + (o[2] * o[2] + o[3] * o[3]); }
                    ss += __shfl_xor(ss, 16); ss += __shfl_xor(ss, 32);
                    if (fq == 0) P[(ai * HALF + wr * 64 + m * 16 + fr) * 4 + wc] = ss;
                    asm volatile("" ::: "memory"); }
        }
        asm volatile("s_waitcnt lgkmcnt(0)" ::: "memory"); __builtin_amdgcn_s_barrier(); asm volatile("" ::: "memory");
        const int row = wid * 32 + (lane & 31);
        if (lane < 32) { const f32x4 q = *(const LAS f32x4*)(P + row * 4); __hip_atomic_store(xch + (size_t)(u.pm * BM + row) * 4 + u.pn, (q[0] + q[1]) + (q[2] + q[3]), __ATOMIC_RELAXED, __HIP_MEMORY_SCOPE_AGENT); }
        asm volatile("s_waitcnt vmcnt(0)" ::: "memory");
        if (lane == 0) (void)__hip_atomic_fetch_add(pcnt + 64 * u.pm, 1u, __ATOMIC_RELAXED, __HIP_MEMORY_SCOPE_AGENT);
        if (wid == 0) {
            unsigned spins = 0;
            while ((unsigned)__builtin_amdgcn_readfirstlane(__hip_atomic_load(pcnt + 64 * u.pm, __ATOMIC_RELAXED, __HIP_MEMORY_SCOPE_AGENT)) < 32u) { __builtin_amdgcn_s_sleep(2); if (++spins > (1u << 20)) break; }
            __builtin_amdgcn_fence(__ATOMIC_ACQUIRE, "agent");
        }
        asm volatile("s_waitcnt vmcnt(0) lgkmcnt(0)" ::: "memory"); __builtin_amdgcn_s_barrier(); asm volatile("" ::: "memory");
        if (lane < 32) { const float* xp = xch + (size_t)(u.pm * BM + row) * 4; float t = 0.f;
#pragma unroll
            for (int k = 0; k < 4; ++k) t += __hip_atomic_load(xp + k, __ATOMIC_RELAXED, __HIP_MEMORY_SCOPE_AGENT);
            const float r = rsqrtf(t * (1.f / D) + EPS); S[row] = r;
            if (MODE == 2 && u.pn == 0) rst[u.pm * BM + row] = r; }
        if (MODE == 2) return;
        if (MODE == 3) {
            asm volatile("s_waitcnt lgkmcnt(0)" ::: "memory"); __builtin_amdgcn_s_barrier(); asm volatile("" ::: "memory");
            const int win = 2 << u.pn, hw = win >> 1; const size_t mo = (size_t)(u.pm >> 5) * mstride;
            LAS float* T = (LAS float*)(lds + wid * 16384);
            LAS bf16_t* T2 = (LAS bf16_t*)(lds + wid * 16384 + 9216);
#pragma unroll
            for (int bj = 0; bj < 2; ++bj) {
                f32x4 wv[2], sv[2];
#pragma unroll
                for (int n = 0; n < 2; ++n) { const int co = col0 + bj * HALF + n * 16; wv[n] = *(const f32x4*)(va + co) * (*(const f32x4*)(sc + mo + co) + 1.f); sv[n] = *(const f32x4*)(sh + mo + co); }
#pragma unroll
                for (int ai = 0; ai < 2; ++ai) {
#pragma unroll
                    for (int m = 0; m < 4; ++m)
#pragma unroll
                        for (int n = 0; n < 2; ++n) { const int r = m * 16 + fr; const f32x4 xn = acc[ai][bj][m][n] * S[ai * HALF + wr * 64 + r] * wv[n] + sv[n]; acc[ai][bj][m][n] = xn;
                            *(LAS f32x4*)(T + r * 36 + n * 16 + 4 * fq) = xn; }
                    {
                        const int cc = lane & 31, r0 = (lane >> 5) * 32; float sm = 0.f, cnt = 0.f;
                        for (int d = -hw; d < hw; ++d) { const int rr = r0 + d; const bool ok = rr >= 0; const float v = T[(ok ? rr : 0) * 36 + cc]; sm += ok ? v : 0.f; cnt += ok ? 1.f : 0.f; }
#pragma unroll 4
                        for (int i = 0; i < 32; ++i) { const int r = r0 + i; const float x = T[r * 36 + cc];
                            T2[r * 40 + cc] = f2bf(sm * __builtin_amdgcn_rcpf(cnt) - x);
                            const int ra = r + hw, rb = r - hw; const bool oka = ra < 64, okb = rb >= 0;
                            const float va2 = T[(oka ? ra : 0) * 36 + cc], vb2 = T[(okb ? rb : 0) * 36 + cc];
                            sm += (oka ? va2 : 0.f) - (okb ? vb2 : 0.f); cnt += (oka ? 1.f : 0.f) - (okb ? 1.f : 0.f); }
                    }
#pragma unroll
                    for (int m = 0; m < 4; ++m)
#pragma unroll
                        for (int n = 0; n < 2; ++n) { const int r = m * 16 + fr;
                            *(u32x2*)(XN + (size_t)(u.pm * BM + ai * HALF + wr * 64 + r) * D + col0 + bj * HALF + n * 16) = *(const LAS u32x2*)(T2 + r * 40 + n * 16 + 4 * fq); }
                    asm volatile("s_waitcnt lgkmcnt(0)" ::: "memory");
                }
            }
            return;
        }
        asm volatile("s_waitcnt lgkmcnt(0)" ::: "memory"); __builtin_amdgcn_s_barrier(); asm volatile("" ::: "memory");
        const size_t mo = MODE == 1 ? (size_t)(u.pm >> 5) * mstride : 0;
#pragma unroll
        for (int bj = 0; bj < 2; ++bj)
#pragma unroll
            for (int n = 0; n < 2; ++n) { const int co = col0 + bj * HALF + n * 16; f32x4 wv = *(const f32x4*)(va + co), sv = {0.f, 0.f, 0.f, 0.f};
                if (MODE == 1) { wv = wv * (*(const f32x4*)(sc + mo + co) + 1.f); sv = *(const f32x4*)(sh + mo + co); }
#pragma unroll
                for (int ai = 0; ai < 2; ++ai)
#pragma unroll
                    for (int m = 0; m < 4; ++m) { const int r = ai * HALF + wr * 64 + m * 16 + fr; const float rs = S[r]; const size_t off = (size_t)(u.pm * BM + r) * D + co;
                        const f32x4 y = acc[ai][bj][m][n] * rs * wv + sv;
                        if (MODE == 0) NTS(y, (f32x4*)(out + off)); else *(u32x2*)(XN + off) = (u32x2){cvt_pk_bf16(y[0], y[1]), cvt_pk_bf16(y[2], y[3])}; } }
    }
};
template <int LDA, int LDB, int KK>
__device__ __forceinline__ void kloop_acc(LAS unsigned char* lds, const char* cA, const char* cB, f32x4 (&acc)[2][2][4][2]) {
    int tid = threadIdx.x; asm volatile("" : "+v"(tid));
    const int wid = __builtin_amdgcn_readfirstlane(tid >> 6), lane = tid & 63, wr = wid >> 2, wc = wid & 3, fr = lane & 15, fq = lane >> 4;
    constexpr int nt = KK / BK;
    unsigned voffA[2], voffB[2];
#pragma unroll
    for (int i = 0; i < 2; ++i) { int R, C; stage_rc(tid * 16 + i * 8192, R, C); voffA[i] = (unsigned)(R * LDA + C) * 2u; voffB[i] = (unsigned)(R * LDB + C) * 2u; }
    constexpr size_t kstep = (size_t)(BK * 2), hstepA = (size_t)HALF * LDA * 2, hstepB = (size_t)HALF * LDB * 2;
    const unsigned ldsw = (unsigned)wid * 1024u;
    const int aoff = lds_byte(wr * 64 + fr, fq * 8), boff = lds_byte(wc * 32 + fr, fq * 8);
#define PG8_SA(b, h) (((b) * 2 + (h)) * HTB)
#define PG8_SB(b, h) ((4 + (b) * 2 + (h)) * HTB)
#define PG8_STAGE(bufoff, gbase, voff) do { _Pragma("unroll") for (int _i = 0; _i < 2; ++_i) \
        __builtin_amdgcn_global_load_lds((const unsigned*)((const char*)(gbase) + (voff)[_i]), (LAS unsigned*)(lds + (bufoff) + ldsw + _i * 8192), 16, 0, 0); } while (0)
#define PG8_LDA(dst, b, h) do { _Pragma("unroll") for (int m = 0; m < 4; ++m) _Pragma("unroll") for (int k = 0; k < 2; ++k) dst[m][k] = *(const LAS bf16x8*)(lds + PG8_SA(b, h) + aoff + m * 2048 + k * 1024); } while (0)
#define PG8_LDB(dst, b, h) do { _Pragma("unroll") for (int n = 0; n < 2; ++n) _Pragma("unroll") for (int k = 0; k < 2; ++k) dst[n][k] = *(const LAS bf16x8*)(lds + PG8_SB(b, h) + boff + n * 2048 + k * 1024); } while (0)
#define PG8_MMA(ai, bj, At, Bt) do { __builtin_amdgcn_s_setprio(1); _Pragma("unroll") for (int m = 0; m < 4; ++m) _Pragma("unroll") for (int n = 0; n < 2; ++n) _Pragma("unroll") for (int k = 0; k < 2; ++k) \
        acc[ai][bj][m][n] = __builtin_amdgcn_mfma_f32_16x16x32_bf16(Bt[n][k], At[m][k], acc[ai][bj][m][n], 0, 0, 0); __builtin_amdgcn_s_setprio(0); } while (0)
#define PG8_WAIT_V(n) asm volatile("s_waitcnt vmcnt(" #n ")" ::: "memory")
#define PG8_WAIT_L(n) asm volatile("s_waitcnt lgkmcnt(" #n ")" ::: "memory")
#define PG8_BAR __builtin_amdgcn_s_barrier()
#define PG8_SCHED __builtin_amdgcn_sched_barrier(0)
    bf16x8 At[4][2], B0[2][2], B1[2][2];
    PG8_STAGE(PG8_SB(0, 0), cB, voffB); PG8_STAGE(PG8_SB(0, 1), cB + hstepB, voffB); PG8_STAGE(PG8_SA(0, 0), cA, voffA); PG8_STAGE(PG8_SA(0, 1), cA + hstepA, voffA);
    if (wr == 1) PG8_BAR;
    PG8_WAIT_V(2); PG8_BAR;
    PG8_STAGE(PG8_SB(1, 0), cB + kstep, voffB); PG8_STAGE(PG8_SA(1, 0), cA + kstep, voffA); PG8_STAGE(PG8_SB(1, 1), cB + hstepB + kstep, voffB);
    PG8_WAIT_V(6); PG8_BAR;
    for (int t = 0; t < nt; t += 2) {
        const bool last = (t == nt - 2);
        const char* a1 = cA + (size_t)(t + 1) * kstep;
        const char* a2 = last ? cA : cA + (size_t)(t + 2) * kstep; const char* b2 = last ? cB : cB + (size_t)(t + 2) * kstep;
        const char* a3 = a2 + kstep; const char* b3 = b2 + kstep;
        PG8_LDB(B0, 0, 0); PG8_LDB(B1, 0, 1); PG8_SCHED; PG8_LDA(At, 0, 0); PG8_STAGE(PG8_SA(1, 1), a1 + hstepA, voffA);
        PG8_WAIT_V(8); PG8_WAIT_L(0); PG8_BAR; PG8_MMA(0, 0, At, B0); PG8_MMA(0, 1, At, B1); PG8_BAR; PG8_SCHED;
        PG8_LDA(At, 0, 1); PG8_STAGE(PG8_SB(0, 0), b2, voffB); PG8_STAGE(PG8_SB(0, 1), b2 + hstepB, voffB); PG8_STAGE(PG8_SA(0, 0), a2, voffA);
        PG8_WAIT_V(8); PG8_WAIT_L(0); PG8_BAR; PG8_MMA(1, 0, At, B0); PG8_MMA(1, 1, At, B1); PG8_BAR; PG8_SCHED;
        PG8_LDB(B0, 1, 0); PG8_LDB(B1, 1, 1); PG8_SCHED; PG8_LDA(At, 1, 0); PG8_STAGE(PG8_SA(0, 1), a2 + hstepA, voffA);
        PG8_WAIT_V(8); PG8_WAIT_L(0); PG8_BAR; PG8_MMA(0, 0, At, B0); PG8_MMA(0, 1, At, B1); PG8_BAR; PG8_SCHED;
        PG8_LDA(At, 1, 1); PG8_STAGE(PG8_SB(1, 0), b3, voffB); PG8_STAGE(PG8_SB(1, 1), b3 + hstepB, voffB); PG8_STAGE(PG8_SA(1, 0), a3, voffA);
        PG8_WAIT_V(8); PG8_WAIT_L(0); PG8_BAR; PG8_MMA(1, 0, At, B0); PG8_MMA(1, 1, At, B1); PG8_BAR; PG8_SCHED;
    }
    PG8_WAIT_V(0);
    if (wr == 0) PG8_BAR;
    PG8_BAR;
#undef PG8_SA
#undef PG8_SB
#undef PG8_STAGE
#undef PG8_LDA
#undef PG8_LDB
#undef PG8_MMA
#undef PG8_WAIT_V
#undef PG8_WAIT_L
#undef PG8_BAR
#undef PG8_SCHED
}
__device__ __forceinline__ void panel_rstd(const f32x4 (&acc)[2][2][4][2], const Unit& u, int wr, int wc, int fr, int fq, LAS unsigned char* lds, int wid, int lane, float* xch, unsigned* pcnt) {
    LAS float* P = (LAS float*)(lds + 131072); LAS float* S = (LAS float*)(lds + 131072 + 4096);
#pragma unroll
    for (int ai = 0; ai < 2; ++ai)
#pragma unroll
        for (int m = 0; m < 4; ++m) { float ss = 0.f;
#pragma unroll
            for (int bj = 0; bj < 2; ++bj)
#pragma unroll
                for (int n = 0; n < 2; ++n) { const f32x4 o = acc[ai][bj][m][n]; ss += (o[0] * o[0] + o[1] * o[1]) + (o[2] * o[2] + o[3] * o[3]); }
            ss += __shfl_xor(ss, 16); ss += __shfl_xor(ss, 32);
            if (fq == 0) P[(ai * HALF + wr * 64 + m * 16 + fr) * 4 + wc] = ss; }
    asm volatile("s_waitcnt lgkmcnt(0)" ::: "memory"); __builtin_amdgcn_s_barrier(); asm volatile("" ::: "memory");
    const int row = wid * 32 + (lane & 31);
    if (lane < 32) { const f32x4 q = *(const LAS f32x4*)(P + row * 4); __hip_atomic_store(xch + (size_t)(u.pm * BM + row) * 4 + u.pn, (q[0] + q[1]) + (q[2] + q[3]), __ATOMIC_RELAXED, __HIP_MEMORY_SCOPE_AGENT); }
    asm volatile("s_waitcnt vmcnt(0)" ::: "memory");
    if (lane == 0) (void)__hip_atomic_fetch_add(pcnt + 64 * u.pm, 1u, __ATOMIC_RELAXED, __HIP_MEMORY_SCOPE_AGENT);
    if (wid == 0) {
        unsigned spins = 0;
        while ((unsigned)__builtin_amdgcn_readfirstlane(__hip_atomic_load(pcnt + 64 * u.pm, __ATOMIC_RELAXED, __HIP_MEMORY_SCOPE_AGENT)) < 32u) { __builtin_amdgcn_s_sleep(2); if (++spins > (1u << 20)) break; }
        __builtin_amdgcn_fence(__ATOMIC_ACQUIRE, "agent");
    }
    asm volatile("s_waitcnt vmcnt(0) lgkmcnt(0)" ::: "memory"); __builtin_amdgcn_s_barrier(); asm volatile("" ::: "memory");
    if (lane < 32) { const float* xp = xch + (size_t)(u.pm * BM + row) * 4; float t = 0.f;
#pragma unroll
        for (int k = 0; k < 4; ++k) t += __hip_atomic_load(xp + k, __ATOMIC_RELAXED, __HIP_MEMORY_SCOPE_AGENT);
        S[row] = rsqrtf(t * (1.f / D) + EPS); }
    asm volatile("s_waitcnt lgkmcnt(0)" ::: "memory"); __builtin_amdgcn_s_barrier(); asm volatile("" ::: "memory");
}
struct EpiPoolFused {
    static constexpr bool PERM = false, DRAIN_LAST = true;
    float* out; const float* gate; int gstride; float* xch1; unsigned* pcnt1; float* xch2; unsigned* pcnt2;
    const float* ng1; const float* sc1; const float* sh1; const float* ng2; const float* sc2; const float* sh2; int mstride; bf16_t* XN; const bf16_t* PoolG;
    __device__ __forceinline__ void operator()(const f32x4 (&acc)[2][2][4][2], const Unit& u, int wr, int wc, int fr, int fq) const {}
    __device__ __forceinline__ void drained(f32x4 (&acc)[2][2][4][2], const Unit& u, int wr, int wc, int fr, int fq, LAS unsigned char* lds, int wid, int lane) const {
        const int row0 = u.pm * BM + wr * 64 + fr, col0 = u.pn * BM + wc * 32 + 4 * fq, bb = u.pm >> 5;
        LAS float* S = (LAS float*)(lds + 131072 + 4096);
        {
            const float* gp = gate + (size_t)bb * gstride + col0;
            f32x4 gv[2][2];
#pragma unroll
            for (int bj = 0; bj < 2; ++bj)
#pragma unroll
                for (int n = 0; n < 2; ++n) gv[bj][n] = *(const f32x4*)(gp + bj * HALF + n * 16);
#pragma unroll
            for (int ai = 0; ai < 2; ++ai)
#pragma unroll
                for (int m = 0; m < 4; ++m) { const size_t off = (size_t)(row0 + ai * HALF + m * 16) * D + col0;
#pragma unroll
                    for (int bj = 0; bj < 2; ++bj)
#pragma unroll
                        for (int n = 0; n < 2; ++n) { const f32x4 bs = NTL((const f32x4*)(out + off + bj * HALF + n * 16)); acc[ai][bj][m][n] = bs + gv[bj][n] * acc[ai][bj][m][n]; }
                    asm volatile("" : "+v"(acc[ai][0][m][0]), "+v"(acc[ai][0][m][1]), "+v"(acc[ai][1][m][0]), "+v"(acc[ai][1][m][1]));
                    asm volatile("" ::: "memory"); }
        }
        panel_rstd(acc, u, wr, wc, fr, fq, lds, wid, lane, xch1, pcnt1);
        {
            int t1 = threadIdx.x; asm volatile("" : "+v"(t1)); const int w1 = __builtin_amdgcn_readfirstlane(t1 >> 6), lane = t1 & 63, wid = w1;
            const int wr = w1 >> 2, wc = w1 & 3, fr = lane & 15, fq = lane >> 4, col0 = u.pn * BM + wc * 32 + 4 * fq;
            const int win = 2 << u.pn, hw = win >> 1; const size_t mo = (size_t)bb * mstride;
            LAS float* T = (LAS float*)(lds + wid * 16384); LAS bf16_t* T2 = (LAS bf16_t*)(lds + wid * 16384 + 9216);
#pragma unroll
            for (int bj = 0; bj < 2; ++bj) {
                f32x4 wv[2], sv[2];
#pragma unroll
                for (int n = 0; n < 2; ++n) { const int co = col0 + bj * HALF + n * 16; wv[n] = *(const f32x4*)(ng1 + co) * (*(const f32x4*)(sc1 + mo + co) + 1.f); sv[n] = *(const f32x4*)(sh1 + mo + co); }
#pragma unroll
                for (int ai = 0; ai < 2; ++ai) {
#pragma unroll
                    for (int m = 0; m < 4; ++m)
#pragma unroll
                        for (int n = 0; n < 2; ++n) { const int r = m * 16 + fr; *(LAS f32x4*)(T + r * 36 + n * 16 + 4 * fq) = acc[ai][bj][m][n] * S[ai * HALF + wr * 64 + r] * wv[n] + sv[n]; }
                    {   const int cc = lane & 31, r0 = (lane >> 5) * 32; float sm = 0.f, cnt = 0.f;
                        for (int d = -hw; d < hw; ++d) { const int rr = r0 + d; const bool ok = rr >= 0; const float v = T[(ok ? rr : 0) * 36 + cc]; sm += ok ? v : 0.f; cnt += ok ? 1.f : 0.f; }
#pragma unroll 4
                        for (int i = 0; i < 32; ++i) { const int r = r0 + i; const float x = T[r * 36 + cc];
                            T2[r * 40 + cc] = f2bf(sm * __builtin_amdgcn_rcpf(cnt) - x);
                            const int ra = r + hw, rb = r - hw; const bool oka = ra < 64, okb = rb >= 0;
                            const float va2 = T[(oka ? ra : 0) * 36 + cc], vb2 = T[(okb ? rb : 0) * 36 + cc];
                            sm += (oka ? va2 : 0.f) - (okb ? vb2 : 0.f); cnt += (oka ? 1.f : 0.f) - (okb ? 1.f : 0.f); }
                    }
#pragma unroll
                    for (int m = 0; m < 4; ++m)
#pragma unroll
                        for (int n = 0; n < 2; ++n) { const int r = m * 16 + fr;
                            *(u32x2*)(XN + (size_t)(u.pm * BM + ai * HALF + wr * 64 + r) * D + col0 + bj * HALF + n * 16) = *(const LAS u32x2*)(T2 + r * 40 + n * 16 + 4 * fq); }
                    asm volatile("s_waitcnt lgkmcnt(0)" ::: "memory");
                }
            }
        }
        asm volatile("s_waitcnt vmcnt(0)" ::: "memory"); __builtin_amdgcn_fence(__ATOMIC_ACQUIRE, "agent"); asm volatile("s_waitcnt vmcnt(0) lgkmcnt(0)" ::: "memory"); __builtin_amdgcn_s_barrier(); asm volatile("" ::: "memory");
        kloop_acc<D, 256, 256>(lds, (const char*)(XN + (size_t)u.pm * BM * D + u.pn * 256), (const char*)(PoolG + ((size_t)bb * 1024 + u.pn * 256) * 256), acc);
        { int t2 = threadIdx.x; asm volatile("" : "+v"(t2)); const int w2 = __builtin_amdgcn_readfirstlane(t2 >> 6), l2 = t2 & 63;
          panel_rstd(acc, u, w2 >> 2, w2 & 3, l2 & 15, l2 >> 4, lds, w2, l2, xch2, pcnt2); }
        {
            int t3 = threadIdx.x; asm volatile("" : "+v"(t3)); const int w3 = __builtin_amdgcn_readfirstlane(t3 >> 6), l3 = t3 & 63;
            const int wr = w3 >> 2, wc = w3 & 3, fr = l3 & 15, fq = l3 >> 4, col0 = u.pn * BM + wc * 32 + 4 * fq;
            const size_t mo = (size_t)bb * mstride;
#pragma unroll
            for (int bj = 0; bj < 2; ++bj)
#pragma unroll
                for (int n = 0; n < 2; ++n) { const int co = col0 + bj * HALF + n * 16; const f32x4 wv = *(const f32x4*)(ng2 + co) * (*(const f32x4*)(sc2 + mo + co) + 1.f), sv = *(const f32x4*)(sh2 + mo + co);
#pragma unroll
                    for (int ai = 0; ai < 2; ++ai)
#pragma unroll
                        for (int m = 0; m < 4; ++m) { const int r = ai * HALF + wr * 64 + m * 16 + fr; const float rs = S[r]; const size_t off = (size_t)(u.pm * BM + r) * D + co;
                            const f32x4 o = acc[ai][bj][m][n]; NTS(o, (f32x4*)(out + off));
                            const f32x4 y = o * rs * wv + sv; *(u32x2*)(XN + off) = (u32x2){cvt_pk_bf16(y[0], y[1]), cvt_pk_bf16(y[2], y[3])}; } }
        }
    }
};
}

__device__ __forceinline__ void transpose_item(const float* W, int K, int N, bf16_t* WT, LAS float* scr, int item, int lane) {
    const int nblk = N / 32, kb = item / nblk, nb = item % nblk, k0 = 64 * kb, n0 = 32 * nb;
#pragma unroll 8
    for (int i = 0; i < 32; ++i) { const int kk = 2 * i + (lane >> 5); scr[kk * 33 + (lane & 31)] = NTL(&W[(size_t)(k0 + kk) * N + n0 + (lane & 31)]); }
    asm volatile("s_waitcnt lgkmcnt(0)" ::: "memory");
    const int c = lane & 7;
#pragma unroll
    for (int j = 0; j < 4; ++j) { const int n = (lane >> 3) + 8 * j; const LAS float* s = scr + (8 * c) * 33 + n;
        u32x4 o; o.x = cvt_pk_bf16(s[0 * 33], s[1 * 33]); o.y = cvt_pk_bf16(s[2 * 33], s[3 * 33]); o.z = cvt_pk_bf16(s[4 * 33], s[5 * 33]); o.w = cvt_pk_bf16(s[6 * 33], s[7 * 33]);
        *(u32x4*)(WT + (size_t)(n0 + n) * K + k0 + 8 * c) = o; }
    asm volatile("s_waitcnt lgkmcnt(0)" ::: "memory");
}

__device__ __forceinline__ void p0_phase(const Params& p, LAS unsigned char* lds, int, int, int) {
    int tid = threadIdx.x; asm volatile("" : "+v"(tid)); const int lane = tid & 63, wave = __builtin_amdgcn_readfirstlane(tid >> 6);
    unsigned char* ws = p.ws;
    {
        LAS float* sv = (LAS float*)lds;
        LAS float* red = (LAS float*)(lds + 12288);
        for (int i = tid; i < 3 * 1024; i += 512) { const int v = i >> 10, k = i & 1023; const float c = v < 2 ? p.c[v * 1024 + k] : p.c_ctx[k]; sv[i] = c / (1.f + __expf(-c)); }
        __syncthreads();
        float* MOD = (float*)(ws + WS_MOD);
        for (int item = blockIdx.x; item < 192; item += gridDim.x) {
            const int l = item / 96, n0 = (item % 96) * 64; const int cgp = tid & 15, kg = tid >> 4;
            const float* W = p.ada_w + (size_t)l * 1024 * 6144 + n0 + cgp * 4;
            f32x4 a0 = {0.f, 0.f, 0.f, 0.f}, a1 = a0, a2 = a0;
#pragma unroll 8
            for (int k = kg; k < 1024; k += 32) { const f32x4 w = NTL((const f32x4*)(W + (size_t)k * 6144)); a0 += w * sv[k]; a1 += w * sv[1024 + k]; a2 += w * sv[2048 + k]; }
            LAS float* r = red + (kg * 16 + cgp) * 12;
#pragma unroll
            for (int j = 0; j < 4; ++j) { r[j] = a0[j]; r[4 + j] = a1[j]; r[8 + j] = a2[j]; }
            __syncthreads();
            if (tid < 192) { const int cg2 = tid / 12, e = tid % 12, v = e >> 2, j = e & 3; float s = 0.f;
                for (int k2 = 0; k2 < 32; ++k2) s += red[(k2 * 16 + cg2) * 12 + e];
                const int n = n0 + cg2 * 4 + j; const float val = s + p.ada_b[l * 6144 + n];
                if (item < 32) __hip_atomic_store(MOD + (size_t)(l * 3 + v) * 6144 + n, val, __ATOMIC_RELAXED, __HIP_MEMORY_SCOPE_AGENT);
                else MOD[(size_t)(l * 3 + v) * 6144 + n] = val; }
            asm volatile("s_waitcnt vmcnt(0)" ::: "memory");
            __syncthreads();
            if (item < 32 && tid == 0) (void)__hip_atomic_fetch_add((unsigned*)(ws + WS_BAR) + 4000, 1u, __ATOMIC_RELAXED, __HIP_MEMORY_SCOPE_AGENT);
        }
    }
    __syncthreads();
    LAS float* scr = (LAS float*)(lds + wave * 16384);
    const int gw = blockIdx.x * 8 + wave, NGW = gridDim.x * 8;
    constexpr int I_IN = 16 * 97, I_OUT = 16 * 32, I_W1 = 16 * 128, I_W2 = 64 * 32, I_PL = 4 * 8;
    constexpr int NITEMS = I_IN + I_OUT + 2 * I_W1 + 2 * I_W2 + 4 * I_PL;
    for (int it = gw; it < NITEMS; it += NGW) {
        int r = it;
        if (r < I_IN) { transpose_item(p.w_in, 1024, NIN, (bf16_t*)(ws + WS_WIN), scr, r, lane); continue; } r -= I_IN;
        if (r < I_OUT) { transpose_item(p.w_out, 1024, 1024, (bf16_t*)(ws + WS_WOUT), scr, r, lane); continue; } r -= I_OUT;
        if (r < 2 * I_W1) { const int l = r / I_W1; transpose_item(p.w1 + (size_t)l * 1024 * FF, 1024, FF, (bf16_t*)(ws + WS_W1) + (size_t)l * FF * 1024, scr, r % I_W1, lane); continue; } r -= 2 * I_W1;
        if (r < 2 * I_W2) { const int l = r / I_W2; transpose_item(p.w2 + (size_t)l * FF * 1024, FF, 1024, (bf16_t*)(ws + WS_W2) + (size_t)l * 1024 * FF, scr, r % I_W2, lane); continue; } r -= 2 * I_W2;
        { const int g = r / I_PL; transpose_item(p.pool_w + (size_t)g * 65536, 256, 256, (bf16_t*)(ws + WS_POOL) + (size_t)g * 65536, scr, r % I_PL, lane); }
    }
    { u32x4* z = (u32x4*)((bf16_t*)(ws + WS_WIN) + (size_t)NIN * 1024); const int nz = (NIN_PAD - NIN) * 1024 * 2 / 16;
      for (int i = blockIdx.x * 512 + tid; i < nz; i += gridDim.x * 512) z[i] = (u32x4){0u, 0u, 0u, 0u}; }
}

__device__ __forceinline__ void norm_group(const float* src, bf16_t* dst, const float* g, const float* sc, const float* sh, int lane) {
    f32x4 wv[4], sv[4];
#pragma unroll
    for (int j = 0; j < 4; ++j) { const int col = 4 * lane + 256 * j; const f32x4 gg = *(const f32x4*)(g + col), s1 = *(const f32x4*)(sc + col); wv[j] = gg * (s1 + 1.f); sv[j] = *(const f32x4*)(sh + col); }
    for (int r = 0; r < 8; ++r) {
        const f32x4* xr = (const f32x4*)(src + (size_t)r * D) + lane;
        f32x4 v[4]; float s = 0.f;
#pragma unroll
        for (int j = 0; j < 4; ++j) { v[j] = NTL(xr + 64 * j); s += (v[j].x * v[j].x + v[j].y * v[j].y) + (v[j].z * v[j].z + v[j].w * v[j].w); }
        const float rstd = rsqrtf(wave_sum(s) * (1.f / D) + EPS);
        unsigned long long* o8 = (unsigned long long*)(dst + (size_t)r * D) + lane;
#pragma unroll
        for (int j = 0; j < 4; ++j) { const f32x4 y = v[j] * rstd * wv[j] + sv[j]; o8[64 * j] = (unsigned long long)cvt_pk_bf16(y.x, y.y) | ((unsigned long long)cvt_pk_bf16(y.z, y.w) << 32); }
    }
}
__device__ __forceinline__ void norm_phase(const Params& p, const float* src, const float* g, int l, int j0, bool with_ctx, int, int) {
    int tid = threadIdx.x; asm volatile("" : "+v"(tid)); const int lane = tid & 63, wave = __builtin_amdgcn_readfirstlane(tid >> 6);
    const float* MOD = (const float*)(p.ws + WS_MOD); bf16_t* XN = (bf16_t*)(p.ws + WS_XN);
    const int gw = blockIdx.x * 8 + wave, NGW = gridDim.x * 8;
    for (int rg = gw; rg < MROWS / 8; rg += NGW) { const int b = rg >> 10; const float* m = MOD + (size_t)(l * 3 + b) * 6144;
        norm_group(src + (size_t)rg * 8 * D, XN + (size_t)rg * 8 * D, g, m + (j0 + 1) * 1024, m + j0 * 1024, lane); }
    if (with_ctx) { const float* m = MOD + (size_t)(l * 3 + 2) * 6144;
        for (int rg = gw; rg < 2 * CTXL / 8; rg += NGW) norm_group(p.ctx + (size_t)rg * 8 * D, XN + (size_t)(MROWS + rg * 8) * D, g, m + (j0 + 1) * 1024, m + j0 * 1024, lane); }
}
__device__ __forceinline__ void final_norm_phase(const Params& p, int, int) {
    int tid = threadIdx.x; asm volatile("" : "+v"(tid)); const int lane = tid & 63, wave = __builtin_amdgcn_readfirstlane(tid >> 6);
    const int gw = blockIdx.x * 8 + wave, NGW = gridDim.x * 8;
    f32x4 wv[4];
#pragma unroll
    for (int j = 0; j < 4; ++j) wv[j] = *(const f32x4*)(p.final_g + 4 * lane + 256 * j);
    for (int row = gw; row < MROWS; row += NGW) {
        f32x4* xr = (f32x4*)(p.out + (size_t)row * D) + lane;
        f32x4 v[4]; float s = 0.f;
#pragma unroll
        for (int j = 0; j < 4; ++j) { v[j] = xr[64 * j]; s += (v[j].x * v[j].x + v[j].y * v[j].y) + (v[j].z * v[j].z + v[j].w * v[j].w); }
        const float rstd = rsqrtf(wave_sum(s) * (1.f / D) + EPS);
#pragma unroll
        for (int j = 0; j < 4; ++j) xr[64 * j] = v[j] * rstd * wv[j];
    }
}
__device__ __forceinline__ void pool_phase(const Params& p, LAS unsigned char* lds, const float* rst) {
    int tid = threadIdx.x; asm volatile("" : "+v"(tid)); const int lane = tid & 63, wave = __builtin_amdgcn_readfirstlane(tid >> 6);
    const float* MOD = (const float*)(p.ws + WS_MOD); bf16_t* P = (bf16_t*)(p.ws + WS_XN);
    LAS float* T = (LAS float*)lds;
    LAS float* rs = (LAS float*)(lds + 65536);
    const float* src = p.out;
    if (blockIdx.x == 0) { float* GS = (float*)(p.ws + WS_GS); for (int i = tid; i < 2048; i += 512) GS[i] = MOD[(size_t)(3 + (i >> 10)) * 6144 + 2 * 1024 + (i & 1023)] * p.pool_scale[i & 1023]; }
    for (int unit = blockIdx.x; unit < MROWS / 64; unit += gridDim.x) {
        const int t0 = unit * 64, b = unit >> 7; const float* m = MOD + (size_t)(3 + b) * 6144;
        if (rst) { if (tid < 64) rs[tid] = rst[t0 + tid]; }
        else for (int r = 0; r < 8; ++r) { const int t = wave * 8 + r; const f32x4* xr = (const f32x4*)(src + (size_t)(t0 + t) * D) + lane; float s = 0.f;
#pragma unroll
            for (int j = 0; j < 4; ++j) { const f32x4 v = xr[64 * j]; s += (v.x * v.x + v.y * v.y) + (v.z * v.z + v.w * v.w); }
            const float rstd = rsqrtf(wave_sum(s) * (1.f / D) + EPS); if (lane == 0) rs[t] = rstd; }
        __syncthreads();
#pragma unroll 1
        for (int g = 0; g < 4; ++g) {
            const int win = 2 << g, c4 = tid & 63, col = g * 256 + c4 * 4;
            const f32x4 wv = *(const f32x4*)(p.norm1_g + 1024 + col) * (*(const f32x4*)(m + 1024 + col) + 1.f), sv = *(const f32x4*)(m + col);
#pragma unroll 4
            for (int i = 0; i < 8; ++i) { const int t = (tid >> 6) + 8 * i; const f32x4 v = *(const f32x4*)(src + (size_t)(t0 + t) * D + col);
                *(LAS f32x4*)(T + t * 256 + c4 * 4) = v * rs[t] * wv + sv; }
            __syncthreads();
#pragma unroll 1
            for (int i = 0; i < 8; ++i) { const int t = (tid >> 6) + 8 * i; int lo = t - win / 2, hi = lo + win; lo = lo < 0 ? 0 : lo; hi = hi > 64 ? 64 : hi;
                f32x4 s = {0.f, 0.f, 0.f, 0.f};
                for (int tt = lo; tt < hi; ++tt) s += *(LAS f32x4*)(T + tt * 256 + c4 * 4);
                const f32x4 o = s * (1.f / (float)(hi - lo)) - *(LAS f32x4*)(T + t * 256 + c4 * 4);
                *(u32x2*)(P + (size_t)(t0 + t) * D + col) = (u32x2){cvt_pk_bf16(o.x, o.y), cvt_pk_bf16(o.z, o.w)}; }
            __syncthreads();
        }
    }
}

constexpr int PV = 144, PK = 80;
typedef short s16x4 __attribute__((ext_vector_type(4)));
__device__ __forceinline__ bf16x8 tr_frag(const LAS bf16_t* img, int pitch, int r0, int c0, int fr, int fq) {
    const LAS bf16_t* a = img + (r0 + 4 * fq + (fr >> 2)) * pitch + c0 + 4 * (fr & 3);
    const s16x4 lo = __builtin_amdgcn_ds_read_tr16_b64_v4i16((LAS s16x4*)a), hi = __builtin_amdgcn_ds_read_tr16_b64_v4i16((LAS s16x4*)(a + 16 * pitch));
    return __builtin_shufflevector(lo, hi, 0, 1, 2, 3, 4, 5, 6, 7);
}
__device__ __forceinline__ void p3a_phase(const Params& p, LAS unsigned char* lds, int, int, int) {
    int tid = threadIdx.x; asm volatile("" : "+v"(tid)); const int lane = tid & 63, wave = __builtin_amdgcn_readfirstlane(tid >> 6);
    unsigned char* ws = p.ws;
    const bf16_t* Kb = (const bf16_t*)(ws + WS_K); const bf16_t* Vb = (const bf16_t*)(ws + WS_V); const float* G = (const float*)(ws + WS_G);
    bf16_t* DC = (bf16_t*)(ws + WS_DC); float* DN = (float*)(ws + WS_DN); float* BG = (float*)(ws + WS_BG);
    LAS bf16_t* VS = (LAS bf16_t*)lds; LAS bf16_t* KS = (LAS bf16_t*)(lds + 18432);
    LAS float* wts = (LAS float*)(lds + 38912);
    const int fr = lane & 15, fq = lane >> 4;
    const int s = tid >> 3, d0 = (tid & 7) * 8;
    constexpr int NU = 16 * NPOS;
    u32x4 kraw, vraw[2]; float li = 0.f, lf = 0.f;
#define P3A_LOAD(U) do { const int cc_ = (U) % NPOS, bh_ = (U) / NPOS, b_ = bh_ >> 3, h_ = bh_ & 7; \
        const int r0_ = cc_ < 4 ? MROWS + b_ * CTXL + cc_ * 64 : b_ * SEQ + (cc_ - 4) * 64; \
        kraw = *(const u32x4*)(Kb + (size_t)(r0_ + s) * 512 + h_ * 64 + d0); \
        _Pragma("unroll") for (int i = 0; i < 2; ++i) { const int pc = tid + 512 * i; vraw[i] = *(const u32x4*)(Vb + (size_t)(r0_ + (pc >> 4)) * 1024 + h_ * 128 + (pc & 15) * 8); } \
        if (wave < 2) { const float* gp = G + (size_t)(r0_ + lane) * 32 + wave * 16 + h_; li = gp[0]; lf = gp[8]; } } while (0)
    int unit = blockIdx.x;
    if (unit < NU) P3A_LOAD(unit);
    for (; unit < NU; unit += gridDim.x) {
        const int cc = unit % NPOS, bh = unit / NPOS;
        if (wave < 2) {
            const int dir = wave;
            const float pre = wave_incl_sum(lf, lane); const float tot = __shfl(pre, 63);
            const float gg = dir == 0 ? (tot - pre + li) : (pre - lf + li);
            const float Gm = wave_max(gg);
            wts[dir * 64 + lane] = __expf(gg - Gm);
            if (lane == 0) { const int pos = dir == 0 ? cc : (cc < 4 ? 3 - cc : 135 - cc); float* bg = BG + (size_t)((bh * 2 + dir) * NPOS + pos) * 2; bg[0] = tot; bg[1] = Gm; }
        }
        __syncthreads();
        { const float wf = wts[s], wb = wts[64 + s]; const unsigned kr[4] = {kraw.x, kraw.y, kraw.z, kraw.w}; u32x4 kf, kb;
#pragma unroll
          for (int i = 0; i < 4; ++i) { const float k0 = bf_lo(kr[i]), k1 = bf_hi(kr[i]); kf[i] = cvt_pk_bf16(k0 * wf, k1 * wf); kb[i] = cvt_pk_bf16(k0 * wb, k1 * wb); }
          *(LAS u32x4*)(KS + s * PK + d0) = kf; *(LAS u32x4*)(KS + (64 + s) * PK + d0) = kb;
#pragma unroll
          for (int i = 0; i < 2; ++i) { const int pc = tid + 512 * i; *(LAS u32x4*)(VS + (pc >> 4) * PV + (pc & 15) * 8) = vraw[i]; }
        }
        if (unit + (int)gridDim.x < NU) P3A_LOAD(unit + (int)gridDim.x);
        __syncthreads();
        {
            const int dir = wave >> 2, vq = wave & 3; const LAS bf16_t* KSd = KS + dir * 64 * PK;
            const int pos = dir == 0 ? cc : (cc < 4 ? 3 - cc : 135 - cc); const size_t slot = (size_t)((bh * 2 + dir) * NPOS + pos);
            f32x4 acc[4][2];
#pragma unroll
            for (int dt = 0; dt < 4; ++dt) { acc[dt][0] = (f32x4){0.f, 0.f, 0.f, 0.f}; acc[dt][1] = acc[dt][0]; }
#pragma unroll
            for (int ks = 0; ks < 2; ++ks) {
                bf16x8 a[4], bv[2];
#pragma unroll
                for (int dt = 0; dt < 4; ++dt) a[dt] = tr_frag(KSd, PK, ks * 32, dt * 16, fr, fq);
#pragma unroll
                for (int vt = 0; vt < 2; ++vt) bv[vt] = tr_frag(VS, PV, ks * 32, vq * 32 + vt * 16, fr, fq);
#pragma unroll
                for (int dt = 0; dt < 4; ++dt)
#pragma unroll
                    for (int vt = 0; vt < 2; ++vt) acc[dt][vt] = __builtin_amdgcn_mfma_f32_16x16x32_bf16(a[dt], bv[vt], acc[dt][vt], 0, 0, 0);
            }
            bf16_t* dc = DC + slot * 8192;
#pragma unroll
            for (int dt = 0; dt < 4; ++dt)
#pragma unroll
                for (int vt = 0; vt < 2; ++vt) { const int v = vq * 32 + vt * 16 + fr, d = dt * 16 + 4 * fq; const f32x4 a = acc[dt][vt];
                    *(u32x2*)(dc + v * 64 + d) = (u32x2){cvt_pk_bf16(a[0], a[1]), cvt_pk_bf16(a[2], a[3])}; }
            if (tid < 128) { const int dr = tid >> 6, d = tid & 63; const LAS bf16_t* kr = KS + dr * 64 * PK + d; float sm = 0.f;
#pragma unroll 16
                for (int s2 = 0; s2 < 64; ++s2) sm += bf2f(kr[s2 * PK]);
                const int pos2 = dr == 0 ? cc : (cc < 4 ? 3 - cc : 135 - cc); DN[(size_t)((bh * 2 + dr) * NPOS + pos2) * 64 + d] = sm; }
        }
        __syncthreads();
    }
#undef P3A_LOAD
}
__device__ __forceinline__ void p3b_phase(const Params& p, LAS unsigned char* lds) {
    int tid = threadIdx.x; asm volatile("" : "+v"(tid));
    unsigned char* ws = p.ws;
    unsigned* DC = (unsigned*)(ws + WS_DC); f32x2* DN = (f32x2*)(ws + WS_DN); const f32x2* BG = (const f32x2*)(ws + WS_BG); float* MS = (float*)(ws + WS_MS);
    for (int item = blockIdx.x; item < 256; item += gridDim.x) {
        const int seq = item >> 3, pair = (item & 7) * 512 + tid; const bool nth = pair < 32;
        unsigned* dc = DC + (size_t)seq * NPOS * 4096 + pair; f32x2* dn = DN + (size_t)seq * NPOS * 32 + pair; const f32x2* bg = BG + (size_t)seq * NPOS;
        LAS f32x2* bgl = (LAS f32x2*)lds;
        __syncthreads();
        if (tid < NPOS) bgl[tid] = bg[tid];
        __syncthreads();
        float c0 = 0.f, c1 = 0.f, n0 = 0.f, n1 = 0.f, m = 0.f;
        for (int pb = 0; pb < NPOS; pb += 12) {
            unsigned raw[12]; f32x2 g2[12]; f32x2 dnv[12];
#pragma unroll
            for (int i = 0; i < 12; ++i) { raw[i] = NTL(dc + (size_t)(pb + i) * 4096); g2[i] = bgl[pb + i]; dnv[i] = nth ? dn[(size_t)(pb + i) * 32] : (f32x2){0.f, 0.f}; }
#pragma unroll
            for (int i = 0; i < 12; ++i) { const int pp = pb + i;
                if (pp >= 4) { dc[(size_t)pp * 4096] = cvt_pk_bf16(c0, c1); if (nth) dn[(size_t)pp * 32] = (f32x2){n0, n1}; if (pair == 0) MS[seq * NPOS + pp] = m; }
                const float B = g2[i].x, Gm = g2[i].y, mn = fmaxf(B + m, Gm), a = __expf(B + m - mn), bb = __expf(Gm - mn);
                c0 = a * c0 + bb * bf_lo(raw[i]); c1 = a * c1 + bb * bf_hi(raw[i]); n0 = a * n0 + bb * dnv[i].x; n1 = a * n1 + bb * dnv[i].y; m = mn; }
        }
    }
}
__device__ __forceinline__ void p3c_phase(const Params& p, LAS unsigned char* lds, int, int, int) {
    int tid = threadIdx.x; asm volatile("" : "+v"(tid)); const int lane = tid & 63, wave = __builtin_amdgcn_readfirstlane(tid >> 6);
    unsigned char* ws = p.ws;
    const bf16_t* Qb = (const bf16_t*)(ws + WS_Q); const bf16_t* Kb = (const bf16_t*)(ws + WS_K); const bf16_t* Vb = (const bf16_t*)(ws + WS_V); const bf16_t* SO = (const bf16_t*)(ws + WS_SO);
    const float* G = (const float*)(ws + WS_G); const bf16_t* DC = (const bf16_t*)(ws + WS_DC); const float* DN = (const float*)(ws + WS_DN); const float* MS = (const float*)(ws + WS_MS);
    bf16_t* Y = (bf16_t*)(ws + WS_XN);
    constexpr int BUFE = 64 * PV + 2 * 64 * PK;
    LAS bf16_t* VS0 = (LAS bf16_t*)lds;
    constexpr int CSE = 128 * PK;
    LAS bf16_t* CS0 = (LAS bf16_t*)(lds + 2 * BUFE * 2);
    LAS float* GA = (LAS float*)(lds + 2 * BUFE * 2 + 2 * CSE * 2);
    LAS float* SSQ = (LAS float*)(lds + 2 * BUFE * 2 + 2 * CSE * 2 + 20480);
    const int fr = lane & 15, fq = lane >> 4;
    const int tw = wave & 3, vh = wave >> 2, t = tw * 16 + fr;
    constexpr int NU = 16 * 128;
    const int G_ = (int)gridDim.x;
#define P3C_VLOAD(U, dst) do { const int c_ = (U) & 127, bh_ = (U) >> 7, b_ = bh_ >> 3, h_ = bh_ & 7, r0_ = b_ * SEQ + c_ * 64; \
        _Pragma("unroll") for (int i = 0; i < 2; ++i) { const int pc = tid + 512 * i; dst[i] = NTL((const u32x4*)(Vb + (size_t)(r0_ + (pc >> 4)) * 1024 + h_ * 128 + (pc & 15) * 8)); } \
        dst[2] = NTL((const u32x4*)(Kb + (size_t)(r0_ + (tid >> 3)) * 512 + h_ * 64 + (tid & 7) * 8)); dst[3] = NTL((const u32x4*)(Qb + (size_t)(r0_ + (tid >> 3)) * 512 + h_ * 64 + (tid & 7) * 8)); \
        { const bf16_t* cs_ = DC + (size_t)((bh_ * 2) * NPOS + 4 + c_) * 8192; dst[4] = NTL((const u32x4*)(cs_ + (size_t)tid * 8)); dst[5] = NTL((const u32x4*)(cs_ + (size_t)(tid + 512) * 8)); } } while (0)
#define P3C_VSTORE(buf, srcv) do { _Pragma("unroll") for (int i = 0; i < 2; ++i) { const int pc = tid + 512 * i; *(LAS u32x4*)(VS0 + (buf) * BUFE + (pc >> 4) * PV + (pc & 15) * 8) = srcv[i]; } \
        *(LAS u32x4*)(VS0 + (buf) * BUFE + 64 * PV + (tid >> 3) * PK + (tid & 7) * 8) = srcv[2]; *(LAS u32x4*)(VS0 + (buf) * BUFE + 64 * PV + 64 * PK + (tid >> 3) * PK + (tid & 7) * 8) = srcv[3]; \
        *(LAS u32x4*)(CS0 + (buf) * CSE + (tid >> 3) * PK + (tid & 7) * 8) = srcv[4]; *(LAS u32x4*)(CS0 + (buf) * CSE + (64 + (tid >> 3)) * PK + (tid & 7) * 8) = srcv[5]; } while (0)
    for (int ubase = blockIdx.x; ubase < NU; ubase += 8 * G_) {
        int nloc = (NU - ubase + G_ - 1) / G_; nloc = nloc > 8 ? 8 : nloc;
        __syncthreads();
        if (wave < nloc) {
            const int u = ubase + wave * G_, c = u & 127, bh = u >> 7, b = bh >> 3, h = bh & 7, row0 = b * SEQ + c * 64;
#pragma unroll
            for (int dir = 0; dir < 2; ++dir) {
                const int pos = dir ? 63 - lane : lane, slot = (bh * 2 + dir) * NPOS + (dir ? 131 - c : 4 + c);
                const float* gp = G + (size_t)(row0 + pos) * 32 + dir * 16 + h; const float li = gp[0], lf = gp[8], mprev = MS[slot], nvv = DN[(size_t)slot * 64 + lane];
                const float bc = wave_incl_sum(lf, lane), a = li - bc;
                const float Mt = fmaxf(mprev, wave_incl_max(a, lane)), mt = bc + Mt;
                LAS float* ga = GA + (wave * 2 + dir) * 320;
                ga[pos] = a; ga[64 + pos] = Mt; ga[128 + pos] = __expf(-mt); ga[192 + pos] = __expf(mprev - Mt); ga[256 + lane] = nvv;
            }
        }
        u32x4 vnext[6];
        { u32x4 v0[6]; P3C_VLOAD(ubase, v0); if (nloc > 1) P3C_VLOAD(ubase + G_, vnext); P3C_VSTORE(0, v0); }
        __syncthreads();
        for (int j = 0; j < nloc; ++j) {
            const int unit = ubase + j * G_;
            const int c = unit & 127, bh = unit >> 7, b = bh >> 3, h = bh & 7, row0 = b * SEQ + c * 64;
            bf16x8 Bq[2], Kf[4][2], Cf[4][2];
            { const LAS bf16_t* KSi = VS0 + (j & 1) * BUFE + 64 * PV; const LAS bf16_t* QSi = KSi + 64 * PK;
#pragma unroll
              for (int ks = 0; ks < 2; ++ks) Bq[ks] = *(const LAS bf16x8*)(QSi + t * PK + ks * 32 + fq * 8);
#pragma unroll
              for (int st = 0; st < 4; ++st) { Kf[st][0] = *(const LAS bf16x8*)(KSi + (st * 16 + fr) * PK + fq * 8); Kf[st][1] = *(const LAS bf16x8*)(KSi + (st * 16 + fr) * PK + 32 + fq * 8); } }
            { const LAS bf16_t* CSi = CS0 + (j & 1) * CSE;
#pragma unroll
              for (int vt = 0; vt < 4; ++vt) { const LAS bf16_t* cp = CSi + (vh * 64 + vt * 16 + fr) * PK + fq * 8; Cf[vt][0] = *(const LAS bf16x8*)cp; Cf[vt][1] = *(const LAS bf16x8*)(cp + 32); } }
            if (j + 1 < nloc) { P3C_VSTORE((j + 1) & 1, vnext); if (j + 2 < nloc) P3C_VLOAD(unit + 2 * G_, vnext); }
            const LAS bf16_t* VS = VS0 + (j & 1) * BUFE;
            f32x4 ST[4];
#pragma unroll
            for (int st = 0; st < 4; ++st) {
                ST[st] = __builtin_amdgcn_mfma_f32_16x16x32_bf16(Kf[st][0], Bq[0], (f32x4){0.f, 0.f, 0.f, 0.f}, 0, 0, 0);
                ST[st] = __builtin_amdgcn_mfma_f32_16x16x32_bf16(Kf[st][1], Bq[1], ST[st], 0, 0, 0); }
            f32x4 hx[4];
#pragma unroll
            for (int vt = 0; vt < 4; ++vt) hx[vt] = (f32x4){0.f, 0.f, 0.f, 0.f};
#pragma unroll
            for (int dir = 0; dir < 2; ++dir) {
                bf16x8 Cn[4][2];
                if (dir == 0) {
                    const bf16_t* Cp = DC + (size_t)((bh * 2 + 1) * NPOS + 131 - c) * 8192;
#pragma unroll
                    for (int vt = 0; vt < 4; ++vt) { const bf16_t* cp = Cp + (vh * 64 + vt * 16 + fr) * 64 + fq * 8; Cn[vt][0] = NTL((const bf16x8*)cp); Cn[vt][1] = NTL((const bf16x8*)(cp + 32)); }
                }
                const LAS float* ga = GA + (j * 2 + dir) * 320;
                const float Mt = ga[64 + t], en = ga[128 + t], wi = ga[192 + t];
                float den = 0.f; f32x4 sw[4];
#pragma unroll
                for (int st = 0; st < 4; ++st) { const f32x4 a4 = *(const LAS f32x4*)(ga + st * 16 + 4 * fq);
#pragma unroll
                    for (int jj = 0; jj < 4; ++jj) { const int s = st * 16 + 4 * fq + jj; const bool ok = dir == 0 ? (s <= t) : (s >= t);
                        const float w = ok ? __expf(a4[jj] - Mt) : 0.f; sw[st][jj] = ST[st][jj] * w; den += sw[st][jj]; } }
                bf16x8 Bsw[2];
#pragma unroll
                for (int kk = 0; kk < 2; ++kk) { u32x4 w; w.x = cvt_pk_bf16(sw[2 * kk][0], sw[2 * kk][1]); w.y = cvt_pk_bf16(sw[2 * kk][2], sw[2 * kk][3]);
                    w.z = cvt_pk_bf16(sw[2 * kk + 1][0], sw[2 * kk + 1][1]); w.w = cvt_pk_bf16(sw[2 * kk + 1][2], sw[2 * kk + 1][3]); Bsw[kk] = __builtin_bit_cast(bf16x8, w); }
                float nq = 0.f;
#pragma unroll
                for (int ks = 0; ks < 2; ++ks) { const LAS float* np = ga + 256 + ks * 32 + fq * 8; const f32x4 n0 = *(const LAS f32x4*)np, n1 = *(const LAS f32x4*)(np + 4);
#pragma unroll
                    for (int i = 0; i < 4; ++i) { nq += bf2f((unsigned short)Bq[ks][i]) * n0[i]; nq += bf2f((unsigned short)Bq[ks][4 + i]) * n1[i]; } }
                den += __shfl_xor(den, 16); den += __shfl_xor(den, 32); nq += __shfl_xor(nq, 16); nq += __shfl_xor(nq, 32);
                const float inv = 1.f / fmaxf(fabsf(wi * nq + den), en);
#pragma unroll
                for (int vt = 0; vt < 4; ++vt) {
                    f32x4 acc = __builtin_amdgcn_mfma_f32_16x16x32_bf16(Cf[vt][0], Bq[0], (f32x4){0.f, 0.f, 0.f, 0.f}, 0, 0, 0);
                    acc = __builtin_amdgcn_mfma_f32_16x16x32_bf16(Cf[vt][1], Bq[1], acc, 0, 0, 0);
                    acc = acc * wi;
#pragma unroll
                    for (int kk = 0; kk < 2; ++kk) acc = __builtin_amdgcn_mfma_f32_16x16x32_bf16(tr_frag(VS, PV, kk * 32, vh * 64 + vt * 16, fr, fq), Bsw[kk], acc, 0, 0, 0);
                    hx[vt] += acc * inv; }
                if (dir == 0) {
#pragma unroll
                    for (int vt = 0; vt < 4; ++vt) { Cf[vt][0] = Cn[vt][0]; Cf[vt][1] = Cn[vt][1]; }
                }
            }
            u32x2 so[4]; f32x4 ng[4];
#pragma unroll
            for (int vt = 0; vt < 4; ++vt) { const int col = h * 128 + vh * 64 + vt * 16 + 4 * fq; so[vt] = NTL((const u32x2*)(SO + (size_t)(row0 + t) * D + col)); ng[vt] = *(const f32x4*)(p.mnorm_g + col); }
            float ss = 0.f;
#pragma unroll
            for (int vt = 0; vt < 4; ++vt) ss += (hx[vt][0] * hx[vt][0] + hx[vt][1] * hx[vt][1]) + (hx[vt][2] * hx[vt][2] + hx[vt][3] * hx[vt][3]);
            ss += __shfl_xor(ss, 16); ss += __shfl_xor(ss, 32);
            LAS float* ssq = SSQ + (j & 1) * 128;
            if (fq == 0) ssq[vh * 64 + t] = ss;
            __syncthreads();
            const float rstd = rsqrtf((ssq[t] + ssq[64 + t]) * (1.f / DV) + EPS);
#pragma unroll
            for (int vt = 0; vt < 4; ++vt) { const int col = h * 128 + vh * 64 + vt * 16 + 4 * fq; const size_t off = (size_t)(row0 + t) * D + col;
                const float y0 = bf_lo(so[vt].x) * hx[vt][0] * rstd * ng[vt][0], y1 = bf_hi(so[vt].x) * hx[vt][1] * rstd * ng[vt][1], y2 = bf_lo(so[vt].y) * hx[vt][2] * rstd * ng[vt][2], y3 = bf_hi(so[vt].y) * hx[vt][3] * rstd * ng[vt][3];
                *(u32x2*)(Y + off) = (u32x2){cvt_pk_bf16(y0, y1), cvt_pk_bf16(y2, y3)}; }
        }
    }
#undef P3C_VLOAD
#undef P3C_VSTORE
}

__device__ __forceinline__ void in_small_tasks(const Params& p, LAS unsigned char* lds) {
    int tid = threadIdx.x; asm volatile("" : "+v"(tid)); const int lane = tid & 63, wave = __builtin_amdgcn_readfirstlane(tid >> 6), fr = lane & 15, fq = lane >> 4;
    unsigned char* ws = p.ws;
    const bf16_t* XN = (const bf16_t*)(ws + WS_XN); const bf16_t* WT = (const bf16_t*)(ws + WS_WIN);
    bf16_t* Kb = (bf16_t*)(ws + WS_K); bf16_t* Vb = (bf16_t*)(ws + WS_V); float* G = (float*)(ws + WS_G);
    constexpr int NGT = MALL / 64, NCT = (2 * CTXL / 64) * 24, PP = 68;
    LAS float* part = (LAS float*)lds;
    for (int tile = blockIdx.x; tile < NGT + NCT; tile += gridDim.x) {
        int r0, n0; const bool gate = tile < NGT;
        if (gate) { r0 = tile * 64; n0 = 3072; } else { const int e = tile - NGT; r0 = MROWS + (e / 24) * 64; n0 = 512 + (e % 24) * 64; }
        const bf16_t* Ap = XN + (size_t)(r0 + fr) * D + wave * 128 + fq * 8; const bf16_t* Bp = WT + (size_t)(n0 + fr) * D + wave * 128 + fq * 8;
        f32x4 acc[4][4];
#pragma unroll
        for (int m = 0; m < 4; ++m)
#pragma unroll
            for (int n = 0; n < 4; ++n) acc[m][n] = (f32x4){0.f, 0.f, 0.f, 0.f};
        if (gate) {
#pragma unroll
            for (int ks = 0; ks < 4; ++ks) { bf16x8 a[4], b[2];
#pragma unroll
                for (int m = 0; m < 4; ++m) a[m] = NTL((const bf16x8*)(Ap + (size_t)m * 16 * D + ks * 32));
#pragma unroll
                for (int n = 0; n < 2; ++n) b[n] = *(const bf16x8*)(Bp + (size_t)n * 16 * D + ks * 32);
#pragma unroll
                for (int m = 0; m < 4; ++m)
#pragma unroll
                    for (int n = 0; n < 2; ++n) acc[m][n] = __builtin_amdgcn_mfma_f32_16x16x32_bf16(b[n], a[m], acc[m][n], 0, 0, 0); }
        } else {
#pragma unroll
            for (int ks = 0; ks < 4; ++ks) { bf16x8 a[4], b[4];
#pragma unroll
                for (int m = 0; m < 4; ++m) a[m] = *(const bf16x8*)(Ap + (size_t)m * 16 * D + ks * 32);
#pragma unroll
                for (int n = 0; n < 4; ++n) b[n] = *(const bf16x8*)(Bp + (size_t)n * 16 * D + ks * 32);
#pragma unroll
                for (int m = 0; m < 4; ++m)
#pragma unroll
                    for (int n = 0; n < 4; ++n) acc[m][n] = __builtin_amdgcn_mfma_f32_16x16x32_bf16(b[n], a[m], acc[m][n], 0, 0, 0); }
        }
        {   LAS float* pw = part + wave * 64 * PP;
#pragma unroll
            for (int m = 0; m < 4; ++m)
#pragma unroll
                for (int n = 0; n < 4; ++n) if (!gate || n < 2) *(LAS f32x4*)(pw + (m * 16 + fr) * PP + n * 16 + 4 * fq) = acc[m][n]; }
        __syncthreads();
        {   const int row = tid >> 3, c8 = (tid & 7) * 8;
            if (!gate || c8 < 32) {
                f32x4 s0 = {0.f, 0.f, 0.f, 0.f}, s1 = s0;
#pragma unroll
                for (int w = 0; w < 8; ++w) { const LAS float* q = part + (w * 64 + row) * PP + c8; s0 += *(const LAS f32x4*)q; s1 += *(const LAS f32x4*)(q + 4); }
                if (gate) {
                    s0 += *(const f32x4*)(p.gate_b + c8); s1 += *(const f32x4*)(p.gate_b + c8 + 4);
                    const bool fgt = (tid & 1) != 0;
#pragma unroll
                    for (int j = 0; j < 4; ++j) {
                        float t0 = 15.f * (1.f - 2.f * __builtin_amdgcn_rcpf(__expf(s0[j] * (2.f / 15.f)) + 1.f)), t1 = 15.f * (1.f - 2.f * __builtin_amdgcn_rcpf(__expf(s1[j] * (2.f / 15.f)) + 1.f));
                        if (fgt) { t0 = fminf(t0, 0.f) - __logf(1.f + __expf(-fabsf(t0))); t1 = fminf(t1, 0.f) - __logf(1.f + __expf(-fabsf(t1))); }
                        s0[j] = t0; s1[j] = t1; }
                    float* gp = G + (size_t)(r0 + row) * 32 + c8; *(f32x4*)gp = s0; *(f32x4*)(gp + 4) = s1;
                } else {
                    const int col = n0 + c8; const u32x4 w = {cvt_pk_bf16(s0[0], s0[1]), cvt_pk_bf16(s0[2], s0[3]), cvt_pk_bf16(s1[0], s1[1]), cvt_pk_bf16(s1[2], s1[3])};
                    if (col < 1024) *(u32x4*)(Kb + (size_t)(r0 + row) * 512 + (col - 512)) = w; else *(u32x4*)(Vb + (size_t)(r0 + row) * 1024 + (col - 1024)) = w;
                }
            }
        }
        __syncthreads();
    }
}

#define XB_TMO      128
#define XB_XCNT(j)  (256  + 64 * (j))
#define XB_XSUB(j)  (1280 + 64 * (j))
#define XB_XGEN(j)  (2304 + 64 * (j))
#define XB_TOP      3328
#define XB_TOPGEN   3392
#define XCD_BAR_WORDS 3456
#define XB_SPIN_CAP (1u << 18)
__device__ __forceinline__ unsigned xb_ld(unsigned* p)              { return __hip_atomic_load(p, __ATOMIC_RELAXED, __HIP_MEMORY_SCOPE_AGENT); }
__device__ __forceinline__ unsigned xb_add(unsigned* p, unsigned v) { return __hip_atomic_fetch_add(p, v, __ATOMIC_RELAXED, __HIP_MEMORY_SCOPE_AGENT); }
__device__ __forceinline__ unsigned xb_xcc_id() { return (unsigned)__builtin_amdgcn_s_getreg((3 << 11) | 20) & 0xFu; }
#define XB_SPIN(cond, bar) do { unsigned _sp = 0; while (cond) { __builtin_amdgcn_s_sleep(1); \
    if ((++_sp & 255u) == 0u) { if (xb_ld(&(bar)[XB_TMO])) break; if (_sp > XB_SPIN_CAP) { atomicAdd(&(bar)[XB_TMO], 1u); break; } } } } while (0)
__device__ __forceinline__ void xcd_barrier_complete(unsigned* bar, unsigned x, unsigned& nloc, unsigned& nx) {
    const unsigned G = gridDim.x * gridDim.y * gridDim.z;
    unsigned sum, cnt, mine, sp = 0u;
    for (;;) {
        sum = 0u; cnt = 0u; mine = 0u;
#pragma unroll
        for (unsigned j = 0; j < 16; ++j) { const unsigned c = xb_ld(&bar[XB_XCNT(j)]); sum += c; cnt += (c > 0u) ? 1u : 0u; mine = (j == x) ? c : mine; }
        if (sum == G) break;
        __builtin_amdgcn_s_sleep(1);
        if ((++sp & 255u) == 0u) { if (xb_ld(&bar[XB_TMO])) break; if (sp > XB_SPIN_CAP) { atomicAdd(&bar[XB_TMO], 1u); break; } }
    }
    nloc = mine > 0u ? mine : 1u; nx = cnt > 0u ? cnt : 1u;
}
__device__ __forceinline__ void xcd_barrier(unsigned* bar, volatile LAS unsigned* st) {
    asm volatile("s_waitcnt vmcnt(0)" ::: "memory");
    __syncthreads();
    if (threadIdx.x == 0) {
        const unsigned x = xb_xcc_id();
        __builtin_amdgcn_s_waitcnt(0);
        unsigned nloc = st[0], nx = st[1];
        if (nloc == 0u) { xcd_barrier_complete(bar, x, nloc, nx); st[0] = nloc; st[1] = nx; }
        const unsigned old = xb_add(&bar[XB_XSUB(x)], 1u);
        const unsigned gen = old / nloc;
        if (old + 1u == (gen + 1u) * nloc) {
            __builtin_amdgcn_fence(__ATOMIC_RELEASE, "agent");
            asm volatile("s_waitcnt vmcnt(0)" ::: "memory");
            const unsigned og = xb_add(&bar[XB_TOP], 1u);
            const unsigned tg = og / nx;
            if (og + 1u == (tg + 1u) * nx) xb_add(&bar[XB_TOPGEN], 1u);
            else XB_SPIN(xb_ld(&bar[XB_TOPGEN]) == tg, bar);
            __builtin_amdgcn_fence(__ATOMIC_ACQUIRE, "agent");
            xb_add(&bar[XB_XGEN(x)], 1u);
            asm volatile("s_waitcnt vmcnt(0)" ::: "memory");
        } else {
            XB_SPIN(xb_ld(&bar[XB_XGEN(x)]) == gen, bar);
            __builtin_amdgcn_fence(__ATOMIC_ACQUIRE, "agent");
            asm volatile("s_waitcnt vmcnt(0)" ::: "memory");
        }
    }
    __syncthreads();
}
#define GSYNC() do { const Params pb_ = load_params(); xcd_barrier((unsigned*)(pb_.ws + WS_BAR), (volatile LAS unsigned*)(lds + LDS_BYTES - 16)); } while (0)
__device__ __forceinline__ Params load_params() {
#if defined(__HIP_DEVICE_COMPILE__)
    const __attribute__((address_space(4))) Params* kp = (const __attribute__((address_space(4))) Params*)__builtin_amdgcn_kernarg_segment_ptr();
    asm volatile("" : "+s"(kp));
    return *kp;
#else
    return Params{};
#endif
}
template <int L> __device__ __forceinline__ void mlp_layer(LAS unsigned char* lds, cg::grid_group& grid) {
    const bool fused = gridDim.x == 256;
    if (!fused) {
        { const Params p = load_params(); norm_phase(p, p.out, p.norm2_g + L * 1024, L, 3, false, 0, 0); }
        GSYNC();
    }
    {
        const Params p = load_params();
        pg8::Gemm g{(const bf16_t*)(p.ws + WS_XN), (const bf16_t*)(p.ws + WS_W1) + (size_t)L * FF * D}; pg8::StaticOrder S; S.init(MROWS, FF, gridDim.x, blockIdx.x);
        pg8::EpiRelu2 E{(bf16_t*)(p.ws + WS_H)};
        pg8::gemm_phase<pg8::EpiRelu2, pg8::StaticOrder, true, D, D, D, 0>(lds, g, S, E);
    }
    GSYNC();
    {
        const Params p = load_params();
        pg8::Gemm g{(const bf16_t*)(p.ws + WS_H), (const bf16_t*)(p.ws + WS_W2) + (size_t)L * D * FF}; pg8::StaticOrder S; S.init(MROWS, D, gridDim.x, blockIdx.x);
        const float* g2 = (const float*)(p.ws + WS_MOD) + (size_t)L * 3 * 6144 + 5 * 1024;
        if (fused) {
            const float* M1 = (const float*)(p.ws + WS_MOD) + 3 * 6144;
            float* xch = (float*)(p.ws + WS_XCH); unsigned* pc = (unsigned*)(p.ws + WS_PCNT);
            if constexpr (L == 0) {
                pg8::EpiPoolFused E{p.out, g2, 6144, xch + (size_t)1 * MROWS * 4, pc + 1 * 4096, xch + (size_t)2 * MROWS * 4, pc + 2 * 4096,
                    p.norm1_g + 1024, M1 + 1024, M1, p.norm2_g + 1024, M1 + 4 * 1024, M1 + 3 * 1024, 6144, (bf16_t*)(p.ws + WS_XN), (const bf16_t*)(p.ws + WS_POOLG)};
                pg8::gemm_phase<pg8::EpiPoolFused, pg8::StaticOrder, false, FF, FF, FF, 0>(lds, g, S, E);
            } else {
                pg8::EpiNorm<0> E{p.out, p.out, g2, 6144, xch + (size_t)3 * MROWS * 4, pc + 3 * 4096, p.final_g, nullptr, nullptr, 0, nullptr, nullptr};
                pg8::gemm_phase<pg8::EpiNorm<0>, pg8::StaticOrder, false, FF, FF, FF, 0>(lds, g, S, E);
            }
        } else {
            pg8::EpiRes E{p.out, p.out, g2, 6144};
            pg8::gemm_phase<pg8::EpiRes, pg8::StaticOrder, false, FF, FF, FF, 0>(lds, g, S, E);
        }
    }
    if (!(L == 1 && fused)) GSYNC();
}
__global__ void __launch_bounds__(512, 2) fwd_megakernel(Params p_unused) {
    extern __shared__ __attribute__((aligned(16))) unsigned char lds_raw[];
    cg::grid_group grid = cg::this_grid();
    LAS unsigned char* lds = (LAS unsigned char*)lds_raw;
    {   const Params p = load_params();
        if (__builtin_expect(p.ws == nullptr, 0)) grid.sync();
        volatile LAS unsigned* st = (volatile LAS unsigned*)(lds + LDS_BYTES - 16);
        if (threadIdx.x < 4) st[threadIdx.x] = 0u;
        __syncthreads();
        if (threadIdx.x == 0) (void)xb_add(&((unsigned*)(p.ws + WS_BAR))[XB_XCNT(xb_xcc_id())], 1u);
    }
    { const Params p = load_params(); p0_phase(p, lds, 0, 0, 0); }
    {
        const Params p = load_params(); unsigned* mc = (unsigned*)(p.ws + WS_BAR) + 4000;
        if (threadIdx.x < 64) { unsigned spins = 0;
            while ((unsigned)__builtin_amdgcn_readfirstlane(__hip_atomic_load(mc, __ATOMIC_RELAXED, __HIP_MEMORY_SCOPE_AGENT)) < 32u) { __builtin_amdgcn_s_sleep(2); if (++spins > (1u << 20)) break; }
            __builtin_amdgcn_fence(__ATOMIC_ACQUIRE, "agent"); asm volatile("s_waitcnt vmcnt(0)" ::: "memory"); }
        __syncthreads();
        norm_phase(p, p.x, p.norm1_g, 0, 0, true, 0, 0);
    }
    GSYNC();
    { const Params p = load_params();
      if (blockIdx.x == 0) { const float* MODp = (const float*)(p.ws + WS_MOD); float* GS = (float*)(p.ws + WS_GS);
          for (int i = threadIdx.x; i < 2048; i += 512) GS[i] = MODp[(size_t)(3 + (i >> 10)) * 6144 + 2 * 1024 + (i & 1023)] * p.pool_scale[i & 1023]; }
      {
          const float* MODp = (const float*)(p.ws + WS_MOD); const bf16_t* PT = (const bf16_t*)(p.ws + WS_POOL); bf16_t* PG = (bf16_t*)(p.ws + WS_POOLG);
          for (int i = blockIdx.x * 512 + threadIdx.x; i < 2 * 1024 * 256; i += gridDim.x * 512) { const int b = i >> 18, n = (i >> 8) & 1023;
              PG[i] = f2bf(bf2f(PT[i & 262143]) * MODp[(size_t)(3 + b) * 6144 + 2 * 1024 + n] * p.pool_scale[n]); } } }
    {
        const Params p = load_params(); unsigned char* ws = p.ws;
        pg8::Gemm g{(const bf16_t*)(ws + WS_XN), (const bf16_t*)(ws + WS_WIN)}; pg8::InOrder S; S.init(gridDim.x, blockIdx.x);
        pg8::EpiIn E{(bf16_t*)(ws + WS_Q), (bf16_t*)(ws + WS_K), (bf16_t*)(ws + WS_V), (bf16_t*)(ws + WS_SO), (float*)(ws + WS_G), p.gate_b};
        pg8::gemm_phase<pg8::EpiIn, pg8::InOrder, true, D, D, D, 0>(lds, g, S, E);
    }
    { const Params p = load_params(); in_small_tasks(p, lds); }
    GSYNC();
    { const Params p = load_params(); p3a_phase(p, lds, 0, 0, 0); }
    GSYNC();
    { const Params p = load_params(); p3b_phase(p, lds); }
    GSYNC();
    { const Params p = load_params(); p3c_phase(p, lds, 0, 0, 0); }
    GSYNC();
    {
        const Params p = load_params();
        pg8::Gemm g{(const bf16_t*)(p.ws + WS_XN), (const bf16_t*)(p.ws + WS_WOUT)}; pg8::StaticOrder S; S.init(MROWS, D, gridDim.x, blockIdx.x);
        const float* M0 = (const float*)(p.ws + WS_MOD);
        if (gridDim.x == 256) {
            pg8::EpiNorm<1> E{p.x, p.out, M0 + 2 * 1024, 6144, (float*)(p.ws + WS_XCH), (unsigned*)(p.ws + WS_PCNT), p.norm2_g, M0 + 4 * 1024, M0 + 3 * 1024, 6144, (bf16_t*)(p.ws + WS_XN), nullptr};
            pg8::gemm_phase<pg8::EpiNorm<1>, pg8::StaticOrder, false, D, D, D, 0>(lds, g, S, E);
        } else {
            pg8::EpiRes E{p.x, p.out, M0 + 2 * 1024, 6144};
            pg8::gemm_phase<pg8::EpiRes, pg8::StaticOrder, false, D, D, D, 0>(lds, g, S, E);
        }
    }
    GSYNC();
    mlp_layer<0>(lds, grid);
    if (gridDim.x != 256) {
        { const Params p = load_params(); pool_phase(p, lds, nullptr); }
        GSYNC();
    }
    if (gridDim.x != 256) {
        {
            const Params p = load_params();
            pg8::Gemm g{(const bf16_t*)(p.ws + WS_XN), (const bf16_t*)(p.ws + WS_POOL)}; pg8::StaticOrder S; S.init(MROWS, D, gridDim.x, blockIdx.x);
            pg8::EpiRes E{p.out, p.out, (const float*)(p.ws + WS_GS), 1024};
            pg8::gemm_phase<pg8::EpiRes, pg8::StaticOrder, false, D, 256, 256, 256>(lds, g, S, E);
        }
        GSYNC();
    }
    mlp_layer<1>(lds, grid);
    if (gridDim.x != 256) { const Params p = load_params(); final_norm_phase(p, 0, 0); }
}

extern "C" void kernel_launch(void* const* d_in, const int* in_sizes, int n_in, void* d_out, int out_size, void* d_ws, size_t ws_size, hipStream_t stream) {
    static int grid = 0;
    if (grid == 0) {
        int dev = 0, cus = 0, per_cu = 0;
        (void)hipGetDevice(&dev);
        (void)hipDeviceGetAttribute(&cus, hipDeviceAttributeMultiprocessorCount, dev);
        if (hipFuncSetAttribute((const void*)fwd_megakernel, hipFuncAttributeMaxDynamicSharedMemorySize, LDS_BYTES) != hipSuccess) fprintf(stderr, "kernel_launch: hipFuncSetAttribute failed\n");
        if (hipOccupancyMaxActiveBlocksPerMultiprocessor(&per_cu, (const void*)fwd_megakernel, 512, LDS_BYTES) != hipSuccess || per_cu < 1) { fprintf(stderr, "kernel_launch: occupancy query gave %d\n", per_cu); per_cu = 1; }
        (void)hipGetLastError();
        if (cus <= 0) cus = 256;
        grid = cus * per_cu;
    }
    Params p{};
    p.x = (const float*)d_in[0]; p.c = (const float*)d_in[1]; p.ctx = (const float*)d_in[2]; p.c_ctx = (const float*)d_in[3];
    p.ada_w = (const float*)d_in[4]; p.ada_b = (const float*)d_in[5]; p.norm1_g = (const float*)d_in[6]; p.norm2_g = (const float*)d_in[7];
    p.w_in = (const float*)d_in[8]; p.gate_b = (const float*)d_in[9]; p.mnorm_g = (const float*)d_in[10]; p.w_out = (const float*)d_in[11];
    p.pool_w = (const float*)d_in[12]; p.pool_scale = (const float*)d_in[13]; p.w1 = (const float*)d_in[14]; p.w2 = (const float*)d_in[15]; p.final_g = (const float*)d_in[16];
    p.out = (float*)d_out; p.ws = (unsigned char*)d_ws;
    (void)hipMemsetAsync((char*)d_ws + WS_BAR, 0, CTL_BYTES, stream);
    void* args[] = {&p};
    hipError_t e = hipLaunchCooperativeKernel((const void*)fwd_megakernel, dim3(grid), dim3(512), args, LDS_BYTES, stream);
    if (e != hipSuccess) fprintf(stderr, "cooperative launch failed: %s (grid %d)\n", hipGetErrorString(e), grid);
}
```

```cpp
#include <hip/hip_runtime.h>
#include <hip/hip_cooperative_groups.h>
#include <cstdio>
#include <cstdint>
namespace cg = cooperative_groups;

#define LAS __attribute__((address_space(3)))
typedef unsigned short bf16_t;
typedef short bf16x8 __attribute__((ext_vector_type(8)));
typedef short bf16x4 __attribute__((ext_vector_type(4)));
typedef float f32x4 __attribute__((ext_vector_type(4)));
typedef float f32x2 __attribute__((ext_vector_type(2)));
typedef unsigned u32x4 __attribute__((ext_vector_type(4)));
typedef unsigned u32x2 __attribute__((ext_vector_type(2)));

constexpr int D = 1024, SEQ = 8192, MROWS = 16384, CTXL = 256, MALL = MROWS + 2 * CTXL;
constexpr int NH = 8, DQK = 64, DV = 128, FF = 4096, NIN = 3104, NIN_PAD = 3328;
constexpr int NPOS = 132;
constexpr float EPS = 1e-6f;

constexpr size_t MiB = 1u << 20;
constexpr size_t WS_BAR = 0;
constexpr size_t WS_PCNT = 16384;
constexpr size_t CTL_BYTES = 16384 + 4 * 16384;
constexpr size_t WS_XCH = 248 * MiB;
constexpr size_t WS_RST = 249 * MiB;
constexpr size_t WS_MOD = 98304;
constexpr size_t WS_GS = 512 * 1024;
constexpr size_t WS_WIN = 1 * MiB;
constexpr size_t WS_WOUT = 8 * MiB;
constexpr size_t WS_W1 = 10 * MiB;
constexpr size_t WS_W2 = 26 * MiB;
constexpr size_t WS_POOL = 42 * MiB;
constexpr size_t WS_POOLG = 43 * MiB;
constexpr size_t WS_XN = 44 * MiB;
constexpr size_t WS_Q = 78 * MiB;
constexpr size_t WS_K = 94 * MiB;
constexpr size_t WS_V = 111 * MiB;
constexpr size_t WS_SO = 144 * MiB;
constexpr size_t WS_G = 176 * MiB;
constexpr size_t WS_DC = 179 * MiB;
constexpr size_t WS_DN = 245 * MiB;
constexpr size_t WS_BG = 247 * MiB;
constexpr size_t WS_MS = 247 * MiB + 65536;
constexpr size_t WS_H = 78 * MiB;
constexpr int LDS_BYTES = 147456;

struct Params {
    const float *x, *c, *ctx, *c_ctx, *ada_w, *ada_b, *norm1_g, *norm2_g, *w_in, *gate_b, *mnorm_g, *w_out, *pool_w, *pool_scale, *w1, *w2, *final_g;
    float* out; unsigned char* ws;
};

typedef __bf16 bf16v2_t __attribute__((ext_vector_type(2)));
__device__ __forceinline__ unsigned cvt_pk_bf16(float lo, float hi) { const f32x2 v = {lo, hi}; const bf16v2_t r = __builtin_convertvector(v, bf16v2_t); return __builtin_bit_cast(unsigned, r); }
__device__ __forceinline__ float bf_lo(unsigned u) { return __uint_as_float(u << 16); }
__device__ __forceinline__ float bf_hi(unsigned u) { return __uint_as_float(u & 0xffff0000u); }
__device__ __forceinline__ float bf2f(unsigned short b) { return __uint_as_float(((unsigned)b) << 16); }
__device__ __forceinline__ unsigned short f2bf(float f) { return (unsigned short)(cvt_pk_bf16(f, 0.f) & 0xffffu); }
__device__ __forceinline__ float wave_sum(float v) {
#pragma unroll
    for (int o = 1; o < 64; o <<= 1) v += __shfl_xor(v, o);
    return v;
}
__device__ __forceinline__ float wave_max(float v) {
#pragma unroll
    for (int o = 1; o < 64; o <<= 1) v = fmaxf(v, __shfl_xor(v, o));
    return v;
}
__device__ __forceinline__ float wave_incl_sum(float v, int lane) {
#pragma unroll
    for (int o = 1; o < 64; o <<= 1) { const float t = __shfl_up(v, o); if (lane >= o) v += t; }
    return v;
}
__device__ __forceinline__ float wave_incl_max(float v, int lane) {
#pragma unroll
    for (int o = 1; o < 64; o <<= 1) { const float t = __shfl_up(v, o); if (lane >= o) v = fmaxf(v, t); }
    return v;
}
#define NTL(p) __builtin_nontemporal_load(p)
#define NTS(v, p) __builtin_nontemporal_store(v, p)
__device__ __forceinline__ float sigmoidf_(float x) { return __builtin_amdgcn_rcpf(1.f + __expf(-x)); }
__device__ __forceinline__ float log_sigmoid(float x) { return fminf(x, 0.f) - log1pf(expf(-fabsf(x))); }

namespace pg8 {
constexpr int BM = 256, BK = 64, HALF = 128, HTB = HALF * BK * 2, STAGE_BYTES = 8 * HTB, NXCD = 8, WGM = 2;
__host__ __device__ __forceinline__ int lds_byte(int r, int c) { const int st = (r >> 4) * 2 + (c >> 5), rr = r & 15, cc = c & 31, ob = rr * 64 + cc * 2; return st * 1024 + (ob ^ (((ob >> 9) & 1) << 5)); }
__host__ __device__ __forceinline__ void stage_rc(int b, int& R, int& C) { const int st = b / 1024, sb = b % 1024, swz = sb ^ (((sb >> 9) & 1) << 5); R = (st >> 1) * 16 + swz / 64; C = (st & 1) * 32 + (swz % 64) / 2; }
__host__ __device__ __forceinline__ int perm32(int rho) { const int n = rho >> 4, i = rho & 15; return 8 * (i >> 2) + 4 * n + (i & 3); }

struct Unit { int pm, pn; };
struct Gemm { const bf16_t* A; const bf16_t* Bt; };

struct StaticOrder {
    int nM, nN, nwg, G, c;
    __device__ void init(int M, int N, int G_, int c_) { nM = M / BM; nN = N / BM; nwg = nM * nN; G = G_; c = c_; }
    __device__ bool next(int i, Unit& u) const {
        const long L = (long)i * G + c; if (L >= nwg) return false;
        int wgid = (int)L; { const int q = nwg / NXCD, r = nwg % NXCD, xcd = wgid % NXCD, off = wgid / NXCD; wgid = (xcd < r ? xcd * (q + 1) : r * (q + 1) + (xcd - r) * q) + off; }
        const int nig = WGM * nN, gid = wgid / nig, fm = gid * WGM, gsz = (nM - fm) < WGM ? (nM - fm) : WGM;
        u.pm = fm + ((wgid % nig) % gsz); u.pn = (wgid % nig) / gsz; return true;
    }
};
struct InOrder {
    int G, c; StaticOrder S;
    __device__ void init(int G_, int c_) { G = G_; c = c_; S.init(MROWS, 3072, G_, c_); }
    __device__ bool next(int i, Unit& u) const {
        const int L = i * G + c;
        if (L < 768) return S.next(i, u);
        return false;
    }
};

template <class Epi, class Sched, bool ALIGN_EPI, int LDA, int LDB, int KK, int ACOL>
__device__ __forceinline__ void gemm_phase(LAS unsigned char* lds, const Gemm g, const Sched& S, const Epi& E) {
    int tid = threadIdx.x; asm volatile("" : "+v"(tid));
    const int wid = __builtin_amdgcn_readfirstlane(tid >> 6), lane = tid & 63, wr = wid >> 2, wc = wid & 3, fr = lane & 15, fq = lane >> 4;
    constexpr int nt = KK / BK;
    unsigned voffA[2], voffB[2];
#pragma unroll
    for (int i = 0; i < 2; ++i) { int R, C; stage_rc(tid * 16 + i * 8192, R, C); const int Rb = Epi::PERM ? ((R & ~31) + perm32(R & 31)) : R;
        voffA[i] = (unsigned)(R * LDA + C) * 2u; voffB[i] = (unsigned)(Rb * LDB + C) * 2u; }
    constexpr size_t kstep = (size_t)(BK * 2);
    constexpr size_t hstepA = (size_t)HALF * LDA * 2, hstepB = (size_t)HALF * LDB * 2;
    constexpr size_t tstepA = 2 * hstepA, tstepB = 2 * hstepB;
    const unsigned ldsw = (unsigned)wid * 1024u;
    const int aoff = lds_byte(wr * 64 + fr, fq * 8), boff = lds_byte(wc * 32 + fr, fq * 8);
#define PG8_SA(b, h) (((b) * 2 + (h)) * HTB)
#define PG8_SB(b, h) ((4 + (b) * 2 + (h)) * HTB)
#define PG8_STAGE(bufoff, gbase, voff) do { _Pragma("unroll") for (int _i = 0; _i < 2; ++_i) \
        __builtin_amdgcn_global_load_lds((const unsigned*)((const char*)(gbase) + (voff)[_i]), (LAS unsigned*)(lds + (bufoff) + ldsw + _i * 8192), 16, 0, 0); } while (0)
#define PG8_LDA(dst, b, h) do { _Pragma("unroll") for (int m = 0; m < 4; ++m) _Pragma("unroll") for (int k = 0; k < 2; ++k) dst[m][k] = *(const LAS bf16x8*)(lds + PG8_SA(b, h) + aoff + m * 2048 + k * 1024); } while (0)
#define PG8_LDB(dst, b, h) do { _Pragma("unroll") for (int n = 0; n < 2; ++n) _Pragma("unroll") for (int k = 0; k < 2; ++k) dst[n][k] = *(const LAS bf16x8*)(lds + PG8_SB(b, h) + boff + n * 2048 + k * 1024); } while (0)
#define PG8_MMA(ai, bj, At, Bt) do { __builtin_amdgcn_s_setprio(1); _Pragma("unroll") for (int m = 0; m < 4; ++m) _Pragma("unroll") for (int n = 0; n < 2; ++n) _Pragma("unroll") for (int k = 0; k < 2; ++k) \
        acc[ai][bj][m][n] = __builtin_amdgcn_mfma_f32_16x16x32_bf16(Bt[n][k], At[m][k], acc[ai][bj][m][n], 0, 0, 0); __builtin_amdgcn_s_setprio(0); } while (0)
#define PG8_WAIT_V(n) asm volatile("s_waitcnt vmcnt(" #n ")" ::: "memory")
#define PG8_WAIT_L(n) asm volatile("s_waitcnt lgkmcnt(" #n ")" ::: "memory")
#define PG8_BAR __builtin_amdgcn_s_barrier()
#define PG8_SCHED __builtin_amdgcn_sched_barrier(0)
    Unit cur, nxt; int ui = 0;
    if (!S.next(0, cur)) return;
    f32x4 acc[2][2][4][2];
#pragma unroll
    for (int a = 0; a < 2; ++a)
#pragma unroll
        for (int b = 0; b < 2; ++b)
#pragma unroll
            for (int m = 0; m < 4; ++m)
#pragma unroll
                for (int n = 0; n < 2; ++n) acc[a][b][m][n] = (f32x4){0.f, 0.f, 0.f, 0.f};
    bf16x8 At[4][2], B0[2][2], B1[2][2];
    const char* cA = (const char*)g.A + (size_t)cur.pm * tstepA + (size_t)cur.pn * ACOL * 2; const char* cB = (const char*)g.Bt + (size_t)cur.pn * tstepB;
    PG8_STAGE(PG8_SB(0, 0), cB, voffB); PG8_STAGE(PG8_SB(0, 1), cB + hstepB, voffB); PG8_STAGE(PG8_SA(0, 0), cA, voffA); PG8_STAGE(PG8_SA(0, 1), cA + hstepA, voffA);
    if (wr == 1) PG8_BAR;
    PG8_WAIT_V(2); PG8_BAR;
    PG8_STAGE(PG8_SB(1, 0), cB + kstep, voffB); PG8_STAGE(PG8_SA(1, 0), cA + kstep, voffA); PG8_STAGE(PG8_SB(1, 1), cB + hstepB + kstep, voffB);
    PG8_WAIT_V(6); PG8_BAR;
    for (;;) {
        const bool has_next = S.next(ui + 1, nxt);
        const char* nA = has_next ? (const char*)g.A + (size_t)nxt.pm * tstepA + (size_t)nxt.pn * ACOL * 2 : cA; const char* nB = has_next ? (const char*)g.Bt + (size_t)nxt.pn * tstepB : cB;
        for (int t = 0; t < nt; t += 2) {
            const bool last = (t == nt - 2);
            const char* a1 = cA + (size_t)(t + 1) * kstep;
            const char* a2 = last ? nA : cA + (size_t)(t + 2) * kstep; const char* b2 = last ? nB : cB + (size_t)(t + 2) * kstep;
            const char* a3 = a2 + kstep; const char* b3 = b2 + kstep;
            PG8_LDB(B0, 0, 0); PG8_LDB(B1, 0, 1); PG8_SCHED; PG8_LDA(At, 0, 0); PG8_STAGE(PG8_SA(1, 1), a1 + hstepA, voffA);
            PG8_WAIT_V(8); PG8_WAIT_L(0); PG8_BAR; PG8_MMA(0, 0, At, B0); PG8_MMA(0, 1, At, B1); PG8_BAR; PG8_SCHED;
            PG8_LDA(At, 0, 1); PG8_STAGE(PG8_SB(0, 0), b2, voffB); PG8_STAGE(PG8_SB(0, 1), b2 + hstepB, voffB); PG8_STAGE(PG8_SA(0, 0), a2, voffA);
            PG8_WAIT_V(8); PG8_WAIT_L(0); PG8_BAR; PG8_MMA(1, 0, At, B0); PG8_MMA(1, 1, At, B1); PG8_BAR; PG8_SCHED;
            PG8_LDB(B0, 1, 0); PG8_LDB(B1, 1, 1); PG8_SCHED; PG8_LDA(At, 1, 0); PG8_STAGE(PG8_SA(0, 1), a2 + hstepA, voffA);
            PG8_WAIT_V(8); PG8_WAIT_L(0); PG8_BAR; PG8_MMA(0, 0, At, B0); PG8_MMA(0, 1, At, B1); PG8_BAR; PG8_SCHED;
            PG8_LDA(At, 1, 1); PG8_STAGE(PG8_SB(1, 0), b3, voffB); PG8_STAGE(PG8_SB(1, 1), b3 + hstepB, voffB); PG8_STAGE(PG8_SA(1, 0), a3, voffA);
            PG8_WAIT_V(8); PG8_WAIT_L(0); PG8_BAR; PG8_MMA(1, 0, At, B0); PG8_MMA(1, 1, At, B1); PG8_BAR; PG8_SCHED;
        }
        if constexpr (ALIGN_EPI) { if (wr == 0) PG8_BAR; }
        if (!Epi::DRAIN_LAST || has_next) E(acc, cur, wr, wc, fr, fq);
        if (!has_next) break;
#pragma unroll
        for (int a = 0; a < 2; ++a)
#pragma unroll
            for (int b = 0; b < 2; ++b)
#pragma unroll
                for (int m = 0; m < 4; ++m)
#pragma unroll
                    for (int n = 0; n < 2; ++n) acc[a][b][m][n] = (f32x4){0.f, 0.f, 0.f, 0.f};
        cur = nxt; cA = nA; cB = nB; ++ui;
        if constexpr (ALIGN_EPI) { if (wr == 1) PG8_BAR; }
    }
    PG8_WAIT_V(0);
    if constexpr (!ALIGN_EPI) { if (wr == 0) PG8_BAR; }
    PG8_BAR;
    if constexpr (Epi::DRAIN_LAST) E.drained(acc, cur, wr, wc, fr, fq, lds, wid, lane);
#undef PG8_SA
#undef PG8_SB
#undef PG8_STAGE
#undef PG8_LDA
#undef PG8_LDB
#undef PG8_MMA
#undef PG8_WAIT_V
#undef PG8_WAIT_L
#undef PG8_BAR
#undef PG8_SCHED
}

struct EpiIn {
    static constexpr bool PERM = true, DRAIN_LAST = false;
    bf16_t *Q, *Kb, *V, *SO; float* G; const float* gate_b;
    __device__ __forceinline__ void operator()(const f32x4 (&acc)[2][2][4][2], const Unit& u, int wr, int wc, int fr, int fq) const {
        const int row0 = u.pm * BM + wr * 64 + fr; const int pn = u.pn;
        if (pn == 12) {
            if (wc == 0) {
#pragma unroll
                for (int n = 0; n < 2; ++n) {
                    const int c0 = 8 * fq + 4 * n; const f32x4 gb = *(const f32x4*)(gate_b + c0);
#pragma unroll
                    for (int ai = 0; ai < 2; ++ai)
#pragma unroll
                        for (int m = 0; m < 4; ++m) {
                            f32x4 v = acc[ai][0][m][n] + gb;
#pragma unroll
                            for (int j = 0; j < 4; ++j) { float t = 15.f * tanhf(v[j] * (1.f / 15.f)); if (fq & 1) t = log_sigmoid(t); v[j] = t; }
                            *(f32x4*)(G + (size_t)(row0 + ai * HALF + m * 16) * 32 + c0) = v;
                        }
                }
            }
            return;
        }
        bf16_t* base; int ldc, colt; float sc = 1.f; bool sg = false;
        if (pn < 2) { base = Q; ldc = 512; colt = pn * 256; sc = 0.125f; }
        else if (pn < 4) { base = Kb; ldc = 512; colt = (pn - 2) * 256; }
        else if (pn < 8) { base = V; ldc = 1024; colt = (pn - 4) * 256; }
        else { base = SO; ldc = 1024; colt = (pn - 8) * 256; sg = true; }
        const int col0 = colt + wc * 32 + 8 * fq;
#pragma unroll
        for (int ai = 0; ai < 2; ++ai)
#pragma unroll
            for (int m = 0; m < 4; ++m) { bf16_t* rowp = base + (size_t)(row0 + ai * HALF + m * 16) * ldc + col0;
#pragma unroll
                for (int bj = 0; bj < 2; ++bj) { f32x4 v0 = acc[ai][bj][m][0], v1 = acc[ai][bj][m][1];
                    if (sg) {
#pragma unroll
                        for (int j = 0; j < 4; ++j) { v0[j] = sigmoidf_(v0[j]); v1[j] = sigmoidf_(v1[j]); }
                    } else { v0 = v0 * sc; v1 = v1 * sc; }
                    u32x4 w; w.x = cvt_pk_bf16(v0[0], v0[1]); w.y = cvt_pk_bf16(v0[2], v0[3]); w.z = cvt_pk_bf16(v1[0], v1[1]); w.w = cvt_pk_bf16(v1[2], v1[3]);
                    *(u32x4*)(rowp + bj * HALF) = w; } }
    }
};
struct EpiRelu2 {
    static constexpr bool PERM = true, DRAIN_LAST = false;
    bf16_t* H;
    __device__ __forceinline__ void operator()(const f32x4 (&acc)[2][2][4][2], const Unit& u, int wr, int wc, int fr, int fq) const {
        const int row0 = u.pm * BM + wr * 64 + fr, col0 = u.pn * BM + wc * 32 + 8 * fq;
#pragma unroll
        for (int ai = 0; ai < 2; ++ai)
#pragma unroll
            for (int m = 0; m < 4; ++m) { bf16_t* rowp = H + (size_t)(row0 + ai * HALF + m * 16) * FF + col0;
#pragma unroll
                for (int bj = 0; bj < 2; ++bj) { f32x4 v0 = acc[ai][bj][m][0], v1 = acc[ai][bj][m][1];
#pragma unroll
                    for (int j = 0; j < 4; ++j) { const float a = fmaxf(v0[j], 0.f), b = fmaxf(v1[j], 0.f); v0[j] = a * a; v1[j] = b * b; }
                    u32x4 w; w.x = cvt_pk_bf16(v0[0], v0[1]); w.y = cvt_pk_bf16(v0[2], v0[3]); w.z = cvt_pk_bf16(v1[0], v1[1]); w.w = cvt_pk_bf16(v1[2], v1[3]);
                    *(u32x4*)(rowp + bj * HALF) = w; } }
    }
};
struct EpiRes {
    static constexpr bool PERM = false, DRAIN_LAST = true;
    const float* base; float* out; const float* gate; int gstride;
    __device__ __forceinline__ void operator()(const f32x4 (&acc)[2][2][4][2], const Unit& u, int wr, int wc, int fr, int fq) const {
        const int row0 = u.pm * BM + wr * 64 + fr, col0 = u.pn * BM + wc * 32 + 4 * fq;
        const float* gp = gate + (size_t)(u.pm >> 5) * gstride + col0;
        f32x4 gv[2][2];
#pragma unroll
        for (int bj = 0; bj < 2; ++bj)
#pragma unroll
            for (int n = 0; n < 2; ++n) { gv[bj][n] = *(const f32x4*)(gp + bj * HALF + n * 16); }
#pragma unroll
        for (int ai = 0; ai < 2; ++ai)
#pragma unroll
            for (int m = 0; m < 4; ++m) { const size_t off = (size_t)(row0 + ai * HALF + m * 16) * D + col0;
#pragma unroll
                for (int bj = 0; bj < 2; ++bj)
#pragma unroll
                    for (int n = 0; n < 2; ++n) { const f32x4 bs = *(const f32x4*)(base + off + bj * HALF + n * 16); *(f32x4*)(out + off + bj * HALF + n * 16) = bs + gv[bj][n] * acc[ai][bj][m][n]; }
                asm volatile("" ::: "memory"); }
    }
    __device__ __forceinline__ void drained(const f32x4 (&acc)[2][2][4][2], const Unit& u, int wr, int wc, int fr, int fq, LAS unsigned char* lds, int wid, int lane) const {
        const int row0 = u.pm * BM + wr * 64 + fr, col0 = u.pn * BM + wc * 32 + 4 * fq;
        const float* gp = gate + (size_t)(u.pm >> 5) * gstride + col0;
        f32x4 gv[2][2];
#pragma unroll
        for (int bj = 0; bj < 2; ++bj)
#pragma unroll
            for (int n = 0; n < 2; ++n) gv[bj][n] = *(const f32x4*)(gp + bj * HALF + n * 16);
        LAS unsigned char* wb = lds + wid * 16384;
#pragma unroll
        for (int ai = 0; ai < 2; ++ai) {
#pragma unroll
            for (int m = 0; m < 4; ++m)
#pragma unroll
                for (int bj = 0; bj < 2; ++bj)
#pragma unroll
                    for (int n = 0; n < 2; ++n) { const size_t off = (size_t)(row0 + ai * HALF + m * 16) * D + col0 + bj * HALF + n * 16;
                        __builtin_amdgcn_global_load_lds((const unsigned*)(base + off), (LAS unsigned*)(wb + (m * 4 + bj * 2 + n) * 1024), 16, 0, 0); }
            asm volatile("s_waitcnt vmcnt(0)" ::: "memory");
#pragma unroll
            for (int m = 0; m < 4; ++m)
#pragma unroll
                for (int bj = 0; bj < 2; ++bj)
#pragma unroll
                    for (int n = 0; n < 2; ++n) { const size_t off = (size_t)(row0 + ai * HALF + m * 16) * D + col0 + bj * HALF + n * 16;
                        const f32x4 bs = *(const LAS f32x4*)(wb + (m * 4 + bj * 2 + n) * 1024 + lane * 16);
                        *(f32x4*)(out + off) = bs + gv[bj][n] * acc[ai][bj][m][n]; }
            asm volatile("s_waitcnt lgkmcnt(0)" ::: "memory");
        }
    }
};
template <int MODE> struct EpiNorm {
    static constexpr bool PERM = false, DRAIN_LAST = true;
    const float* base; float* out; const float* gate; int gstride; float* xch; unsigned* pcnt; const float* va; const float* sc; const float* sh; int mstride; bf16_t* XN; float* rst;
    __device__ __forceinline__ void operator()(const f32x4 (&acc)[2][2][4][2], const Unit& u, int wr, int wc, int fr, int fq) const {}
    __device__ __forceinline__ void drained(f32x4 (&acc)[2][2][4][2], const Unit& u, int wr, int wc, int fr, int fq, LAS unsigned char* lds, int wid, int lane) const {
        const int row0 = u.pm * BM + wr * 64 + fr, col0 = u.pn * BM + wc * 32 + 4 * fq;
        const float* gp = gate + (size_t)(u.pm >> 5) * gstride + col0;
        LAS float* P = (LAS float*)(lds + 131072); LAS float* S = (LAS float*)(lds + 131072 + 4096);
        {
            f32x4 gv[2][2];
#pragma unroll
            for (int bj = 0; bj < 2; ++bj)
#pragma unroll
                for (int n = 0; n < 2; ++n) gv[bj][n] = *(const f32x4*)(gp + bj * HALF + n * 16);
#pragma unroll
            for (int ai = 0; ai < 2; ++ai)
#pragma unroll
                for (int m = 0; m < 4; ++m) { const size_t off = (size_t)(row0 + ai * HALF + m * 16) * D + col0; float ss = 0.f;
#pragma unroll
                    for (int bj = 0; bj < 2; ++bj)
#pragma unroll
                        for (int n = 0; n < 2; ++n) { const f32x4 bs = NTL((const f32x4*)(base + off + bj * HALF + n * 16)); const f32x4 o = bs + gv[bj][n] * acc[ai][bj][m][n]; acc[ai][bj][m][n] = o;
                            if (MODE != 0) NTS(o, (f32x4*)(out + off + bj * HALF + n * 16));
                            ss += (o[0] * o[0] + o[1] * o[1]) + (o[2] * o[2] + o[3] * o[3]); }
                    ss += __shfl_xor(ss, 16); ss += __shfl_xor(ss, 32);
                    if (fq == 0) P[(ai * HALF + wr * 64 + m * 16 + fr) * 4 + wc] = ss;
                    asm volatile("" ::: "memory"); }
        }
        asm volatile("s_waitcnt lgkmcnt(0)" ::: "memory"); __builtin_amdgcn_s_barrier(); asm volatile("" ::: "memory");
        const int row = wid * 32 + (lane & 31);
        if (lane < 32) { const f32x4 q = *(const LAS f32x4*)(P + row * 4); __hip_atomic_store(xch + (size_t)(u.pm * BM + row) * 4 + u.pn, (q[0] + q[1]) + (q[2] + q[3]), __ATOMIC_RELAXED, __HIP_MEMORY_SCOPE_AGENT); }
        asm volatile("s_waitcnt vmcnt(0)" ::: "memory");
        if (lane == 0) (void)__hip_atomic_fetch_add(pcnt + 64 * u.pm, 1u, __ATOMIC_RELAXED, __HIP_MEMORY_SCOPE_AGENT);
        if (wid == 0) {
            unsigned spins = 0;
            while ((unsigned)__builtin_amdgcn_readfirstlane(__hip_atomic_load(pcnt + 64 * u.pm, __ATOMIC_RELAXED, __HIP_MEMORY_SCOPE_AGENT)) < 32u) { __builtin_amdgcn_s_sleep(2); if (++spins > (1u << 20)) break; }
            __builtin_amdgcn_fence(__ATOMIC_ACQUIRE, "agent");
        }
        asm volatile("s_waitcnt vmcnt(0) lgkmcnt(0)" ::: "memory"); __builtin_amdgcn_s_barrier(); asm volatile("" ::: "memory");
        if (lane < 32) { const float* xp = xch + (size_t)(u.pm * BM + row) * 4; float t = 0.f;
#pragma unroll
            for (int k = 0; k < 4; ++k) t += __hip_atomic_load(xp + k, __ATOMIC_RELAXED, __HIP_MEMORY_SCOPE_AGENT);
            const float r = rsqrtf(t * (1.f / D) + EPS); S[row] = r;
            if (MODE == 2 && u.pn == 0) rst[u.pm * BM + row] = r; }
        if (MODE == 2) return;
        if (MODE == 3) {
            asm volatile("s_waitcnt lgkmcnt(0)" ::: "memory"); __builtin_amdgcn_s_barrier(); asm volatile("" ::: "memory");
            const int win = 2 << u.pn, hw = win >> 1; const size_t mo = (size_t)(u.pm >> 5) * mstride;
            LAS float* T = (LAS float*)(lds + wid * 16384);
            LAS bf16_t* T2 = (LAS bf16_t*)(lds + wid * 16384 + 9216);
#pragma unroll
            for (int bj = 0; bj < 2; ++bj) {
                f32x4 wv[2], sv[2];
#pragma unroll
                for (int n = 0; n < 2; ++n) { const int co = col0 + bj * HALF + n * 16; wv[n] = *(const f32x4*)(va + co) * (*(const f32x4*)(sc + mo + co) + 1.f); sv[n] = *(const f32x4*)(sh + mo + co); }
#pragma unroll
                for (int ai = 0; ai < 2; ++ai) {
#pragma unroll
                    for (int m = 0; m < 4; ++m)
#pragma unroll
                        for (int n = 0; n < 2; ++n) { const int r = m * 16 + fr; const f32x4 xn = acc[ai][bj][m][n] * S[ai * HALF + wr * 64 + r] * wv[n] + sv[n]; acc[ai][bj][m][n] = xn;
                            *(LAS f32x4*)(T + r * 36 + n * 16 + 4 * fq) = xn; }
                    {
                        const int cc = lane & 31, r0 = (lane >> 5) * 32; float sm = 0.f, cnt = 0.f;
                        for (int d = -hw; d < hw; ++d) { const int rr = r0 + d; const bool ok = rr >= 0; const float v = T[(ok ? rr : 0) * 36 + cc]; sm += ok ? v : 0.f; cnt += ok ? 1.f : 0.f; }
#pragma unroll 4
                        for (int i = 0; i < 32; ++i) { const int r = r0 + i; const float x = T[r * 36 + cc];
                            T2[r * 40 + cc] = f2bf(sm * __builtin_amdgcn_rcpf(cnt) - x);
                            const int ra = r + hw, rb = r - hw; const bool oka = ra < 64, okb = rb >= 0;
                            const float va2 = T[(oka ? ra : 0) * 36 + cc], vb2 = T[(okb ? rb : 0) * 36 + cc];
                            sm += (oka ? va2 : 0.f) - (okb ? vb2 : 0.f); cnt += (oka ? 1.f : 0.f) - (okb ? 1.f : 0.f); }
                    }
#pragma unroll
                    for (int m = 0; m < 4; ++m)
#pragma unroll
                        for (int n = 0; n < 2; ++n) { const int r = m * 16 + fr;
                            *(u32x2*)(XN + (size_t)(u.pm * BM + ai * HALF + wr * 64 + r) * D + col0 + bj * HALF + n * 16) = *(const LAS u32x2*)(T2 + r * 40 + n * 16 + 4 * fq); }
                    asm volatile("s_waitcnt lgkmcnt(0)" ::: "memory");
                }
            }
            return;
        }
        asm volatile("s_waitcnt lgkmcnt(0)" ::: "memory"); __builtin_amdgcn_s_barrier(); asm volatile("" ::: "memory");
        const size_t mo = MODE == 1 ? (size_t)(u.pm >> 5) * mstride : 0;
#pragma unroll
        for (int bj = 0; bj < 2; ++bj)
#pragma unroll
            for (int n = 0; n < 2; ++n) { const int co = col0 + bj * HALF + n * 16; f32x4 wv = *(const f32x4*)(va + co), sv = {0.f, 0.f, 0.f, 0.f};
                if (MODE == 1) { wv = wv * (*(const f32x4*)(sc + mo + co) + 1.f); sv = *(const f32x4*)(sh + mo + co); }
#pragma unroll
                for (int ai = 0; ai < 2; ++ai)
#pragma unroll
                    for (int m = 0; m < 4; ++m) { const int r = ai * HALF + wr * 64 + m * 16 + fr; const float rs = S[r]; const size_t off = (size_t)(u.pm * BM + r) * D + co;
                        const f32x4 y = acc[ai][bj][m][n] * rs * wv + sv;
                        if (MODE == 0) NTS(y, (f32x4*)(out + off)); else *(u32x2*)(XN + off) = (u32x2){cvt_pk_bf16(y[0], y[1]), cvt_pk_bf16(y[2], y[3])}; } }
    }
};
template <int LDA, int LDB, int KK>
__device__ __forceinline__ void kloop_acc(LAS unsigned char* lds, const char* cA, const char* cB, f32x4 (&acc)[2][2][4][2]) {
    int tid = threadIdx.x; asm volatile("" : "+v"(tid));
    const int wid = __builtin_amdgcn_readfirstlane(tid >> 6), lane = tid & 63, wr = wid >> 2, wc = wid & 3, fr = lane & 15, fq = lane >> 4;
    constexpr int nt = KK / BK;
    unsigned voffA[2], voffB[2];
#pragma unroll
    for (int i = 0; i < 2; ++i) { int R, C; stage_rc(tid * 16 + i * 8192, R, C); voffA[i] = (unsigned)(R * LDA + C) * 2u; voffB[i] = (unsigned)(R * LDB + C) * 2u; }
    constexpr size_t kstep = (size_t)(BK * 2), hstepA = (size_t)HALF * LDA * 2, hstepB = (size_t)HALF * LDB * 2;
    const unsigned ldsw = (unsigned)wid * 1024u;
    const int aoff = lds_byte(wr * 64 + fr, fq * 8), boff = lds_byte(wc * 32 + fr, fq * 8);
#define PG8_SA(b, h) (((b) * 2 + (h)) * HTB)
#define PG8_SB(b, h) ((4 + (b) * 2 + (h)) * HTB)
#define PG8_STAGE(bufoff, gbase, voff) do { _Pragma("unroll") for (int _i = 0; _i < 2; ++_i) \
        __builtin_amdgcn_global_load_lds((const unsigned*)((const char*)(gbase) + (voff)[_i]), (LAS unsigned*)(lds + (bufoff) + ldsw + _i * 8192), 16, 0, 0); } while (0)
#define PG8_LDA(dst, b, h) do { _Pragma("unroll") for (int m = 0; m < 4; ++m) _Pragma("unroll") for (int k = 0; k < 2; ++k) dst[m][k] = *(const LAS bf16x8*)(lds + PG8_SA(b, h) + aoff + m * 2048 + k * 1024); } while (0)
#define PG8_LDB(dst, b, h) do { _Pragma("unroll") for (int n = 0; n < 2; ++n) _Pragma("unroll") for (int k = 0; k < 2; ++k) dst[n][k] = *(const LAS bf16x8*)(lds + PG8_SB(b, h) + boff + n * 2048 + k * 1024); } while (0)
#define PG8_MMA(ai, bj, At, Bt) do { __builtin_amdgcn_s_setprio(1); _Pragma("unroll") for (int m = 0; m < 4; ++m) _Pragma("unroll") for (int n = 0; n < 2; ++n) _Pragma("unroll") for (int k = 0; k < 2; ++k) \
        acc[ai][bj][m][n] = __builtin_amdgcn_mfma_f32_16x16x32_bf16(Bt[n][k], At[m][k], acc[ai][bj][m][n], 0, 0, 0); __builtin_amdgcn_s_setprio(0); } while (0)
#define PG8_WAIT_V(n) asm volatile("s_waitcnt vmcnt(" #n ")" ::: "memory")
#define PG8_WAIT_L(n) asm volatile("s_waitcnt lgkmcnt(" #n ")" ::: "memory")
#define PG8_BAR __builtin_amdgcn_s_barrier()
#define PG8_SCHED __builtin_amdgcn_sched_barrier(0)
    bf16x8 At[4][2], B0[2][2], B1[2][2];
    PG8_STAGE(PG8_SB(0, 0), cB, voffB); PG8_STAGE(PG8_SB(0, 1), cB + hstepB, voffB); PG8_STAGE(PG8_SA(0, 0), cA, voffA); PG8_STAGE(PG8_SA(0, 1), cA + hstepA, voffA);
    if (wr == 1) PG8_BAR;
    PG8_WAIT_V(2); PG8_BAR;
    PG8_STAGE(PG8_SB(1, 0), cB + kstep, voffB); PG8_STAGE(PG8_SA(1, 0), cA + kstep, voffA); PG8_STAGE(PG8_SB(1, 1), cB + hstepB + kstep, voffB);
    PG8_WAIT_V(6); PG8_BAR;
    for (int t = 0; t < nt; t += 2) {
        const bool last = (t == nt - 2);
        const char* a1 = cA + (size_t)(t + 1) * kstep;
        const char* a2 = last ? cA : cA + (size_t)(t + 2) * kstep; const char* b2 = last ? cB : cB + (size_t)(t + 2) * kstep;
        const char* a3 = a2 + kstep; const char* b3 = b2 + kstep;
        PG8_LDB(B0, 0, 0); PG8_LDB(B1, 0, 1); PG8_SCHED; PG8_LDA(At, 0, 0); PG8_STAGE(PG8_SA(1, 1), a1 + hstepA, voffA);
        PG8_WAIT_V(8); PG8_WAIT_L(0); PG8_BAR; PG8_MMA(0, 0, At, B0); PG8_MMA(0, 1, At, B1); PG8_BAR; PG8_SCHED;
        PG8_LDA(At, 0, 1); PG8_STAGE(PG8_SB(0, 0), b2, voffB); PG8_STAGE(PG8_SB(0, 1), b2 + hstepB, voffB); PG8_STAGE(PG8_SA(0, 0), a2, voffA);
        PG8_WAIT_V(8); PG8_WAIT_L(0); PG8_BAR; PG8_MMA(1, 0, At, B0); PG8_MMA(1, 1, At, B1); PG8_BAR; PG8_SCHED;
        PG8_LDB(B0, 1, 0); PG8_LDB(B1, 1, 1); PG8_SCHED; PG8_LDA(At, 1, 0); PG8_STAGE(PG8_SA(0, 1), a2 + hstepA, voffA);
        PG8_WAIT_V(8); PG8_WAIT_L(0); PG8_BAR; PG8_MMA(0, 0, At, B0); PG8_MMA(0, 1, At, B1); PG8_BAR; PG8_SCHED;
        PG8_LDA(At, 1, 1); PG8_STAGE(PG8_SB(1, 0), b3, voffB); PG8_STAGE(PG8_SB(1, 1), b3 + hstepB, voffB); PG8_STAGE(PG8_SA(1, 0), a3, voffA);
        PG8_WAIT_V(8); PG8_WAIT_L(0); PG8_BAR; PG8_MMA(1, 0, At, B0); PG8_MMA(1, 1, At, B1); PG8_BAR; PG8_SCHED;
    }
    PG8_WAIT_V(0);
    if (wr == 0) PG8_BAR;
    PG8_BAR;
#undef PG8_SA
#undef PG8_SB
#undef PG8_STAGE
#undef PG8_LDA
#undef PG8_LDB
#undef PG8_MMA
#undef PG8_WAIT_V
#undef PG8_WAIT_L
#undef PG8_BAR
#undef PG8_SCHED
}
__device__ __forceinline__ void panel_rstd(const f32x4 (&acc)[2][2][4][2], const Unit& u, int wr, int wc, int fr, int fq, LAS unsigned char* lds, int wid, int lane, float* xch, unsigned* pcnt) {
    LAS float* P = (LAS float*)(lds + 131072); LAS float* S = (LAS float*)(lds + 131072 + 4096);
#pragma unroll
    for (int ai = 0; ai < 2; ++ai)
#pragma unroll
        for (int m = 0; m < 4; ++m) { float ss = 0.f;
#pragma unroll
            for (int bj = 0; bj < 2; ++bj)
#pragma unroll
                for (int n = 0; n < 2; ++n) { const f32x4 o = acc[ai][bj][m][n]; ss += (o[0] * o[0] + o[1] * o[1]) + (o[2] * o[2] + o[3] * o[3]); }
            ss += __shfl_xor(ss, 16); ss += __shfl_xor(ss, 32);
            if (fq == 0) P[(ai * HALF + wr * 64 + m * 16 + fr) * 4 + wc] = ss; }
    asm volatile("s_waitcnt lgkmcnt(0)" ::: "memory"); __builtin_amdgcn_s_barrier(); asm volatile("" ::: "memory");
    const int row = wid * 32 + (lane & 31);
    if (lane < 32) { const f32x4 q = *(const LAS f32x4*)(P + row * 4); __hip_atomic_store(xch + (size_t)(u.pm * BM + row) * 4 + u.pn, (q[0] + q[1]) + (q[2] + q[3]), __ATOMIC_RELAXED, __HIP_MEMORY_SCOPE_AGENT); }
    asm volatile("s_waitcnt vmcnt(0)" ::: "memory");
    if (lane == 0) (void)__hip_atomic_fetch_add(pcnt + 64 * u.pm, 1u, __ATOMIC_RELAXED, __HIP_MEMORY_SCOPE_AGENT);
    if (wid == 0) {
        unsigned spins = 0;
        while ((unsigned)__builtin_amdgcn_readfirstlane(__hip_atomic_load(pcnt + 64 * u.pm, __ATOMIC_RELAXED, __HIP_MEMORY_SCOPE_AGENT)) < 32u) { __builtin_amdgcn_s_sleep(2); if (++spins > (1u << 20)) break; }
        __builtin_amdgcn_fence(__ATOMIC_ACQUIRE, "agent");
    }
    asm volatile("s_waitcnt vmcnt(0) lgkmcnt(0)" ::: "memory"); __builtin_amdgcn_s_barrier(); asm volatile("" ::: "memory");
    if (lane < 32) { const float* xp = xch + (size_t)(u.pm * BM + row) * 4; float t = 0.f;
#pragma unroll
        for (int k = 0; k < 4; ++k) t += __hip_atomic_load(xp + k, __ATOMIC_RELAXED, __HIP_MEMORY_SCOPE_AGENT);
        S[row] = rsqrtf(t * (1.f / D) + EPS); }
    asm volatile("s_waitcnt lgkmcnt(0)" ::: "memory"); __builtin_amdgcn_s_barrier(); asm volatile("" ::: "memory");
}
struct EpiPoolFused {
    static constexpr bool PERM = false, DRAIN_LAST = true;
    float* out; const float* gate; int gstride; float* xch1; unsigned* pcnt1; float* xch2; unsigned* pcnt2;
    const float* ng1; const float* sc1; const float* sh1; const float* ng2; const float* sc2; const float* sh2; int mstride; bf16_t* XN; const bf16_t* PoolG;
    __device__ __forceinline__ void operator()(const f32x4 (&acc)[2][2][4][2], const Unit& u, int wr, int wc, int fr, int fq) const {}
    __device__ __forceinline__ void drained(f32x4 (&acc)[2][2][4][2], const Unit& u, int wr, int wc, int fr, int fq, LAS unsigned char* lds, int wid, int lane) const {
        const int row0 = u.pm * BM + wr * 64 + fr, col0 = u.pn * BM + wc * 32 + 4 * fq, bb = u.pm >> 5;
        LAS float* S = (LAS float*)(lds + 131072 + 4096);
        {
            const float* gp = gate + (size_t)bb * gstride + col0;
            f32x4 gv[2][2];
#pragma unroll
            for (int bj = 0; bj < 2; ++bj)
#pragma unroll
                for (int n = 0; n < 2; ++n) gv[bj][n] = *(const f32x4*)(gp + bj * HALF + n * 16);
#pragma unroll
            for (int ai = 0; ai < 2; ++ai)
#pragma unroll
                for (int m = 0; m < 4; ++m) { const size_t off = (size_t)(row0 + ai * HALF + m * 16) * D + col0;
#pragma unroll
                    for (int bj = 0; bj < 2; ++bj)
#pragma unroll
                        for (int n = 0; n < 2; ++n) { const f32x4 bs = NTL((const f32x4*)(out + off + bj * HALF + n * 16)); acc[ai][bj][m][n] = bs + gv[bj][n] * acc[ai][bj][m][n]; }
                    asm volatile("" : "+v"(acc[ai][0][m][0]), "+v"(acc[ai][0][m][1]), "+v"(acc[ai][1][m][0]), "+v"(acc[ai][1][m][1]));
                    asm volatile("" ::: "memory"); }
        }
        panel_rstd(acc, u, wr, wc, fr, fq, lds, wid, lane, xch1, pcnt1);
        {
            int t1 = threadIdx.x; asm volatile("" : "+v"(t1)); const int w1 = __builtin_amdgcn_readfirstlane(t1 >> 6), lane = t1 & 63, wid = w1;
            const int wr = w1 >> 2, wc = w1 & 3, fr = lane & 15, fq = lane >> 4, col0 = u.pn * BM + wc * 32 + 4 * fq;
            const int win = 2 << u.pn, hw = win >> 1; const size_t mo = (size_t)bb * mstride;
            LAS float* T = (LAS float*)(lds + wid * 16384); LAS bf16_t* T2 = (LAS bf16_t*)(lds + wid * 16384 + 9216);
#pragma unroll
            for (int bj = 0; bj < 2; ++bj) {
                f32x4 wv[2], sv[2];
#pragma unroll
                for (int n = 0; n < 2; ++n) { const int co = col0 + bj * HALF + n * 16; wv[n] = *(const f32x4*)(ng1 + co) * (*(const f32x4*)(sc1 + mo + co) + 1.f); sv[n] = *(const f32x4*)(sh1 + mo + co); }
#pragma unroll
                for (int ai = 0; ai < 2; ++ai) {
#pragma unroll
                    for (int m = 0; m < 4; ++m)
#pragma unroll
                        for (int n = 0; n < 2; ++n) { const int r = m * 16 + fr; *(LAS f32x4*)(T + r * 36 + n * 16 + 4 * fq) = acc[ai][bj][m][n] * S[ai * HALF + wr * 64 + r] * wv[n] + sv[n]; }
                    {   const int cc = lane & 31, r0 = (lane >> 5) * 32; float sm = 0.f, cnt = 0.f;
                        for (int d = -hw; d < hw; ++d) { const int rr = r0 + d; const bool ok = rr >= 0; const float v = T[(ok ? rr : 0) * 36 + cc]; sm += ok ? v : 0.f; cnt += ok ? 1.f : 0.f; }
#pragma unroll 4
                        for (int i = 0; i < 32; ++i) { const int r = r0 + i; const float x = T[r * 36 + cc];
                            T2[r * 40 + cc] = f2bf(sm * __builtin_amdgcn_rcpf(cnt) - x);
                            const int ra = r + hw, rb = r - hw; const bool oka = ra < 64, okb = rb >= 0;
                            const float va2 = T[(oka ? ra : 0) * 36 + cc], vb2 = T[(okb ? rb : 0) * 36 + cc];
                            sm += (oka ? va2 : 0.f) - (okb ? vb2 : 0.f); cnt += (oka ? 1.f : 0.f) - (okb ? 1.f : 0.f); }
                    }
#pragma unroll
                    for (int m = 0; m < 4; ++m)
#pragma unroll
                        for (int n = 0; n < 2; ++n) { const int r = m * 16 + fr;
                            *(u32x2*)(XN + (size_t)(u.pm * BM + ai * HALF + wr * 64 + r) * D + col0 + bj * HALF + n * 16) = *(const LAS u32x2*)(T2 + r * 40 + n * 16 + 4 * fq); }
                    asm volatile("s_waitcnt lgkmcnt(0)" ::: "memory");
                }
            }
        }
        asm volatile("s_waitcnt vmcnt(0)" ::: "memory"); __builtin_amdgcn_fence(__ATOMIC_ACQUIRE, "agent"); asm volatile("s_waitcnt vmcnt(0) lgkmcnt(0)" ::: "memory"); __builtin_amdgcn_s_barrier(); asm volatile("" ::: "memory");
        kloop_acc<D, 256, 256>(lds, (const char*)(XN + (size_t)u.pm * BM * D + u.pn * 256), (const char*)(PoolG + ((size_t)bb * 1024 + u.pn * 256) * 256), acc);
        { int t2 = threadIdx.x; asm volatile("" : "+v"(t2)); const int w2 = __builtin_amdgcn_readfirstlane(t2 >> 6), l2 = t2 & 63;
          panel_rstd(acc, u, w2 >> 2, w2 & 3, l2 & 15, l2 >> 4, lds, w2, l2, xch2, pcnt2); }
        {
            int t3 = threadIdx.x; asm volatile("" : "+v"(t3)); const int w3 = __builtin_amdgcn_readfirstlane(t3 >> 6), l3 = t3 & 63;
            const int wr = w3 >> 2, wc = w3 & 3, fr = l3 & 15, fq = l3 >> 4, col0 = u.pn * BM + wc * 32 + 4 * fq;
            const size_t mo = (size_t)bb * mstride;
#pragma unroll
            for (int bj = 0; bj < 2; ++bj)
#pragma unroll
                for (int n = 0; n < 2; ++n) { const int co = col0 + bj * HALF + n * 16; const f32x4 wv = *(const f32x4*)(ng2 + co) * (*(const f32x4*)(sc2 + mo + co) + 1.f), sv = *(const f32x4*)(sh2 + mo + co);
#pragma unroll
                    for (int ai = 0; ai < 2; ++ai)
#pragma unroll
                        for (int m = 0; m < 4; ++m) { const int r = ai * HALF + wr * 64 + m * 16 + fr; const float rs = S[r]; const size_t off = (size_t)(u.pm * BM + r) * D + co;
                            const f32x4 o = acc[ai][bj][m][n]; NTS(o, (f32x4*)(out + off));
                            const f32x4 y = o * rs * wv + sv; *(u32x2*)(XN + off) = (u32x2){cvt_pk_bf16(y[0], y[1]), cvt_pk_bf16(y[2], y[3])}; } }
        }
    }
};
}

__device__ __forceinline__ void transpose_item(const float* W, int K, int N, bf16_t* WT, LAS float* scr, int item, int lane) {
    const int nblk = N / 32, kb = item / nblk, nb = item % nblk, k0 = 64 * kb, n0 = 32 * nb;
#pragma unroll 8
    for (int i = 0; i < 32; ++i) { const int kk = 2 * i + (lane >> 5); scr[kk * 33 + (lane & 31)] = NTL(&W[(size_t)(k0 + kk) * N + n0 + (lane & 31)]); }
    asm volatile("s_waitcnt lgkmcnt(0)" ::: "memory");
    const int c = lane & 7;
#pragma unroll
    for (int j = 0; j < 4; ++j) { const int n = (lane >> 3) + 8 * j; const LAS float* s = scr + (8 * c) * 33 + n;
        u32x4 o; o.x = cvt_pk_bf16(s[0 * 33], s[1 * 33]); o.y = cvt_pk_bf16(s[2 * 33], s[3 * 33]); o.z = cvt_pk_bf16(s[4 * 33], s[5 * 33]); o.w = cvt_pk_bf16(s[6 * 33], s[7 * 33]);
        *(u32x4*)(WT + (size_t)(n0 + n) * K + k0 + 8 * c) = o; }
    asm volatile("s_waitcnt lgkmcnt(0)" ::: "memory");
}

__device__ __forceinline__ void p0_phase(const Params& p, LAS unsigned char* lds, int, int, int) {
    int tid = threadIdx.x; asm volatile("" : "+v"(tid)); const int lane = tid & 63, wave = __builtin_amdgcn_readfirstlane(tid >> 6);
    unsigned char* ws = p.ws;
    {
        LAS float* sv = (LAS float*)lds;
        LAS float* red = (LAS float*)(lds + 12288);
        for (int i = tid; i < 3 * 1024; i += 512) { const int v = i >> 10, k = i & 1023; const float c = v < 2 ? p.c[v * 1024 + k] : p.c_ctx[k]; sv[i] = c / (1.f + __expf(-c)); }
        __syncthreads();
        float* MOD = (float*)(ws + WS_MOD);
        for (int item = blockIdx.x; item < 192; item += gridDim.x) {
            const int l = item / 96, n0 = (item % 96) * 64; const int cgp = tid & 15, kg = tid >> 4;
            const float* W = p.ada_w + (size_t)l * 1024 * 6144 + n0 + cgp * 4;
            f32x4 a0 = {0.f, 0.f, 0.f, 0.f}, a1 = a0, a2 = a0;
#pragma unroll 8
            for (int k = kg; k < 1024; k += 32) { const f32x4 w = NTL((const f32x4*)(W + (size_t)k * 6144)); a0 += w * sv[k]; a1 += w * sv[1024 + k]; a2 += w * sv[2048 + k]; }
            LAS float* r = red + (kg * 16 + cgp) * 12;
#pragma unroll
            for (int j = 0; j < 4; ++j) { r[j] = a0[j]; r[4 + j] = a1[j]; r[8 + j] = a2[j]; }
            __syncthreads();
            if (tid < 192) { const int cg2 = tid / 12, e = tid % 12, v = e >> 2, j = e & 3; float s = 0.f;
                for (int k2 = 0; k2 < 32; ++k2) s += red[(k2 * 16 + cg2) * 12 + e];
                const int n = n0 + cg2 * 4 + j; const float val = s + p.ada_b[l * 6144 + n];
                if (item < 32) __hip_atomic_store(MOD + (size_t)(l * 3 + v) * 6144 + n, val, __ATOMIC_RELAXED, __HIP_MEMORY_SCOPE_AGENT);
                else MOD[(size_t)(l * 3 + v) * 6144 + n] = val; }
            asm volatile("s_waitcnt vmcnt(0)" ::: "memory");
            __syncthreads();
            if (item < 32 && tid == 0) (void)__hip_atomic_fetch_add((unsigned*)(ws + WS_BAR) + 4000, 1u, __ATOMIC_RELAXED, __HIP_MEMORY_SCOPE_AGENT);
        }
    }
    __syncthreads();
    LAS float* scr = (LAS float*)(lds + wave * 16384);
    const int gw = blockIdx.x * 8 + wave, NGW = gridDim.x * 8;
    constexpr int I_IN = 16 * 97, I_OUT = 16 * 32, I_W1 = 16 * 128, I_W2 = 64 * 32, I_PL = 4 * 8;
    constexpr int NITEMS = I_IN + I_OUT + 2 * I_W1 + 2 * I_W2 + 4 * I_PL;
    for (int it = gw; it < NITEMS; it += NGW) {
        int r = it;
        if (r < I_IN) { transpose_item(p.w_in, 1024, NIN, (bf16_t*)(ws + WS_WIN), scr, r, lane); continue; } r -= I_IN;
        if (r < I_OUT) { transpose_item(p.w_out, 1024, 1024, (bf16_t*)(ws + WS_WOUT), scr, r, lane); continue; } r -= I_OUT;
        if (r < 2 * I_W1) { const int l = r / I_W1; transpose_item(p.w1 + (size_t)l * 1024 * FF, 1024, FF, (bf16_t*)(ws + WS_W1) + (size_t)l * FF * 1024, scr, r % I_W1, lane); continue; } r -= 2 * I_W1;
        if (r < 2 * I_W2) { const int l = r / I_W2; transpose_item(p.w2 + (size_t)l * FF * 1024, FF, 1024, (bf16_t*)(ws + WS_W2) + (size_t)l * 1024 * FF, scr, r % I_W2, lane); continue; } r -= 2 * I_W2;
        { const int g = r / I_PL; transpose_item(p.pool_w + (size_t)g * 65536, 256, 256, (bf16_t*)(ws + WS_POOL) + (size_t)g * 65536, scr, r % I_PL, lane); }
    }
    { u32x4* z = (u32x4*)((bf16_t*)(ws + WS_WIN) + (size_t)NIN * 1024); const int nz = (NIN_PAD - NIN) * 1024 * 2 / 16;
      for (int i = blockIdx.x * 512 + tid; i < nz; i += gridDim.x * 512) z[i] = (u32x4){0u, 0u, 0u, 0u}; }
}

__device__ __forceinline__ void norm_group(const float* src, bf16_t* dst, const float* g, const float* sc, const float* sh, int lane) {
    f32x4 wv[4], sv[4];
#pragma unroll
    for (int j = 0; j < 4; ++j) { const int col = 4 * lane + 256 * j; const f32x4 gg = *(const f32x4*)(g + col), s1 = *(const f32x4*)(sc + col); wv[j] = gg * (s1 + 1.f); sv[j] = *(const f32x4*)(sh + col); }
    for (int r = 0; r < 8; ++r) {
        const f32x4* xr = (const f32x4*)(src + (size_t)r * D) + lane;
        f32x4 v[4]; float s = 0.f;
#pragma unroll
        for (int j = 0; j < 4; ++j) { v[j] = NTL(xr + 64 * j); s += (v[j].x * v[j].x + v[j].y * v[j].y) + (v[j].z * v[j].z + v[j].w * v[j].w); }
        const float rstd = rsqrtf(wave_sum(s) * (1.f / D) + EPS);
        unsigned long long* o8 = (unsigned long long*)(dst + (size_t)r * D) + lane;
#pragma unroll
        for (int j = 0; j < 4; ++j) { const f32x4 y = v[j] * rstd * wv[j] + sv[j]; o8[64 * j] = (unsigned long long)cvt_pk_bf16(y.x, y.y) | ((unsigned long long)cvt_pk_bf16(y.z, y.w) << 32); }
    }
}
__device__ __forceinline__ void norm_phase(const Params& p, const float* src, const float* g, int l, int j0, bool with_ctx, int, int) {
    int tid = threadIdx.x; asm volatile("" : "+v"(tid)); const int lane = tid & 63, wave = __builtin_amdgcn_readfirstlane(tid >> 6);
    const float* MOD = (const float*)(p.ws + WS_MOD); bf16_t* XN = (bf16_t*)(p.ws + WS_XN);
    const int gw = blockIdx.x * 8 + wave, NGW = gridDim.x * 8;
    for (int rg = gw; rg < MROWS / 8; rg += NGW) { const int b = rg >> 10; const float* m = MOD + (size_t)(l * 3 + b) * 6144;
        norm_group(src + (size_t)rg * 8 * D, XN + (size_t)rg * 8 * D, g, m + (j0 + 1) * 1024, m + j0 * 1024, lane); }
    if (with_ctx) { const float* m = MOD + (size_t)(l * 3 + 2) * 6144;
        for (int rg = gw; rg < 2 * CTXL / 8; rg += NGW) norm_group(p.ctx + (size_t)rg * 8 * D, XN + (size_t)(MROWS + rg * 8) * D, g, m + (j0 + 1) * 1024, m + j0 * 1024, lane); }
}
__device__ __forceinline__ void final_norm_phase(const Params& p, int, int) {
    int tid = threadIdx.x; asm volatile("" : "+v"(tid)); const int lane = tid & 63, wave = __builtin_amdgcn_readfirstlane(tid >> 6);
    const int gw = blockIdx.x * 8 + wave, NGW = gridDim.x * 8;
    f32x4 wv[4];
#pragma unroll
    for (int j = 0; j < 4; ++j) wv[j] = *(const f32x4*)(p.final_g + 4 * lane + 256 * j);
    for (int row = gw; row < MROWS; row += NGW) {
        f32x4* xr = (f32x4*)(p.out + (size_t)row * D) + lane;
        f32x4 v[4]; float s = 0.f;
#pragma unroll
        for (int j = 0; j < 4; ++j) { v[j] = xr[64 * j]; s += (v[j].x * v[j].x + v[j].y * v[j].y) + (v[j].z * v[j].z + v[j].w * v[j].w); }
        const float rstd = rsqrtf(wave_sum(s) * (1.f / D) + EPS);
#pragma unroll
        for (int j = 0; j < 4; ++j) xr[64 * j] = v[j] * rstd * wv[j];
    }
}
__device__ __forceinline__ void pool_phase(const Params& p, LAS unsigned char* lds, const float* rst) {
    int tid = threadIdx.x; asm volatile("" : "+v"(tid)); const int lane = tid & 63, wave = __builtin_amdgcn_readfirstlane(tid >> 6);
    const float* MOD = (const float*)(p.ws + WS_MOD); bf16_t* P = (bf16_t*)(p.ws + WS_XN);
    LAS float* T = (LAS float*)lds;
    LAS float* rs = (LAS float*)(lds + 65536);
    const float* src = p.out;
    if (blockIdx.x == 0) { float* GS = (float*)(p.ws + WS_GS); for (int i = tid; i < 2048; i += 512) GS[i] = MOD[(size_t)(3 + (i >> 10)) * 6144 + 2 * 1024 + (i & 1023)] * p.pool_scale[i & 1023]; }
    for (int unit = blockIdx.x; unit < MROWS / 64; unit += gridDim.x) {
        const int t0 = unit * 64, b = unit >> 7; const float* m = MOD + (size_t)(3 + b) * 6144;
        if (rst) { if (tid < 64) rs[tid] = rst[t0 + tid]; }
        else for (int r = 0; r < 8; ++r) { const int t = wave * 8 + r; const f32x4* xr = (const f32x4*)(src + (size_t)(t0 + t) * D) + lane; float s = 0.f;
#pragma unroll
            for (int j = 0; j < 4; ++j) { const f32x4 v = xr[64 * j]; s += (v.x * v.x + v.y * v.y) + (v.z * v.z + v.w * v.w); }
            const float rstd = rsqrtf(wave_sum(s) * (1.f / D) + EPS); if (lane == 0) rs[t] = rstd; }
        __syncthreads();
#pragma unroll 1
        for (int g = 0; g < 4; ++g) {
            const int win = 2 << g, c4 = tid & 63, col = g * 256 + c4 * 4;
            const f32x4 wv = *(const f32x4*)(p.norm1_g + 1024 + col) * (*(const f32x4*)(m + 1024 + col) + 1.f), sv = *(const f32x4*)(m + col);
#pragma unroll 4
            for (int i = 0; i < 8; ++i) { const int t = (tid >> 6) + 8 * i; const f32x4 v = *(const f32x4*)(src + (size_t)(t0 + t) * D + col);
                *(LAS f32x4*)(T + t * 256 + c4 * 4) = v * rs[t] * wv + sv; }
            __syncthreads();
#pragma unroll 1
            for (int i = 0; i < 8; ++i) { const int t = (tid >> 6) + 8 * i; int lo = t - win / 2, hi = lo + win; lo = lo < 0 ? 0 : lo; hi = hi > 64 ? 64 : hi;
                f32x4 s = {0.f, 0.f, 0.f, 0.f};
                for (int tt = lo; tt < hi; ++tt) s += *(LAS f32x4*)(T + tt * 256 + c4 * 4);
                const f32x4 o = s * (1.f / (float)(hi - lo)) - *(LAS f32x4*)(T + t * 256 + c4 * 4);
                *(u32x2*)(P + (size_t)(t0 + t) * D + col) = (u32x2){cvt_pk_bf16(o.x, o.y), cvt_pk_bf16(o.z, o.w)}; }
            __syncthreads();
        }
    }
}

constexpr int PV = 144, PK = 80;
typedef short s16x4 __attribute__((ext_vector_type(4)));
__device__ __forceinline__ bf16x8 tr_frag(const LAS bf16_t* img, int pitch, int r0, int c0, int fr, int fq) {
    const LAS bf16_t* a = img + (r0 + 4 * fq + (fr >> 2)) * pitch + c0 + 4 * (fr & 3);
    const s16x4 lo = __builtin_amdgcn_ds_read_tr16_b64_v4i16((LAS s16x4*)a), hi = __builtin_amdgcn_ds_read_tr16_b64_v4i16((LAS s16x4*)(a + 16 * pitch));
    return __builtin_shufflevector(lo, hi, 0, 1, 2, 3, 4, 5, 6, 7);
}
__device__ __forceinline__ void p3a_phase(const Params& p, LAS unsigned char* lds, int, int, int) {
    int tid = threadIdx.x; asm volatile("" : "+v"(tid)); const int lane = tid & 63, wave = __builtin_amdgcn_readfirstlane(tid >> 6);
    unsigned char* ws = p.ws;
    const bf16_t* Kb = (const bf16_t*)(ws + WS_K); const bf16_t* Vb = (const bf16_t*)(ws + WS_V); const float* G = (const float*)(ws + WS_G);
    bf16_t* DC = (bf16_t*)(ws + WS_DC); float* DN = (float*)(ws + WS_DN); float* BG = (float*)(ws + WS_BG);
    LAS bf16_t* VS = (LAS bf16_t*)lds; LAS bf16_t* KS = (LAS bf16_t*)(lds + 18432);
    LAS float* wts = (LAS float*)(lds + 38912);
    const int fr = lane & 15, fq = lane >> 4;
    const int s = tid >> 3, d0 = (tid & 7) * 8;
    constexpr int NU = 16 * NPOS;
    u32x4 kraw, vraw[2]; float li = 0.f, lf = 0.f;
#define P3A_LOAD(U) do { const int cc_ = (U) % NPOS, bh_ = (U) / NPOS, b_ = bh_ >> 3, h_ = bh_ & 7; \
        const int r0_ = cc_ < 4 ? MROWS + b_ * CTXL + cc_ * 64 : b_ * SEQ + (cc_ - 4) * 64; \
        kraw = *(const u32x4*)(Kb + (size_t)(r0_ + s) * 512 + h_ * 64 + d0); \
        _Pragma("unroll") for (int i = 0; i < 2; ++i) { const int pc = tid + 512 * i; vraw[i] = *(const u32x4*)(Vb + (size_t)(r0_ + (pc >> 4)) * 1024 + h_ * 128 + (pc & 15) * 8); } \
        if (wave < 2) { const float* gp = G + (size_t)(r0_ + lane) * 32 + wave * 16 + h_; li = gp[0]; lf = gp[8]; } } while (0)
    int unit = blockIdx.x;
    if (unit < NU) P3A_LOAD(unit);
    for (; unit < NU; unit += gridDim.x) {
        const int cc = unit % NPOS, bh = unit / NPOS;
        if (wave < 2) {
            const int dir = wave;
            const float pre = wave_incl_sum(lf, lane); const float tot = __shfl(pre, 63);
            const float gg = dir == 0 ? (tot - pre + li) : (pre - lf + li);
            const float Gm = wave_max(gg);
            wts[dir * 64 + lane] = __expf(gg - Gm);
            if (lane == 0) { const int pos = dir == 0 ? cc : (cc < 4 ? 3 - cc : 135 - cc); float* bg = BG + (size_t)((bh * 2 + dir) * NPOS + pos) * 2; bg[0] = tot; bg[1] = Gm; }
        }
        __syncthreads();
        { const float wf = wts[s], wb = wts[64 + s]; const unsigned kr[4] = {kraw.x, kraw.y, kraw.z, kraw.w}; u32x4 kf, kb;
#pragma unroll
          for (int i = 0; i < 4; ++i) { const float k0 = bf_lo(kr[i]), k1 = bf_hi(kr[i]); kf[i] = cvt_pk_bf16(k0 * wf, k1 * wf); kb[i] = cvt_pk_bf16(k0 * wb, k1 * wb); }
          *(LAS u32x4*)(KS + s * PK + d0) = kf; *(LAS u32x4*)(KS + (64 + s) * PK + d0) = kb;
#pragma unroll
          for (int i = 0; i < 2; ++i) { const int pc = tid + 512 * i; *(LAS u32x4*)(VS + (pc >> 4) * PV + (pc & 15) * 8) = vraw[i]; }
        }
        if (unit + (int)gridDim.x < NU) P3A_LOAD(unit + (int)gridDim.x);
        __syncthreads();
        {
            const int dir = wave >> 2, vq = wave & 3; const LAS bf16_t* KSd = KS + dir * 64 * PK;
            const int pos = dir == 0 ? cc : (cc < 4 ? 3 - cc : 135 - cc); const size_t slot = (size_t)((bh * 2 + dir) * NPOS + pos);
            f32x4 acc[4][2];
#pragma unroll
            for (int dt = 0; dt < 4; ++dt) { acc[dt][0] = (f32x4){0.f, 0.f, 0.f, 0.f}; acc[dt][1] = acc[dt][0]; }
#pragma unroll
            for (int ks = 0; ks < 2; ++ks) {
                bf16x8 a[4], bv[2];
#pragma unroll
                for (int dt = 0; dt < 4; ++dt) a[dt] = tr_frag(KSd, PK, ks * 32, dt * 16, fr, fq);
#pragma unroll
                for (int vt = 0; vt < 2; ++vt) bv[vt] = tr_frag(VS, PV, ks * 32, vq * 32 + vt * 16, fr, fq);
#pragma unroll
                for (int dt = 0; dt < 4; ++dt)
#pragma unroll
                    for (int vt = 0; vt < 2; ++vt) acc[dt][vt] = __builtin_amdgcn_mfma_f32_16x16x32_bf16(a[dt], bv[vt], acc[dt][vt], 0, 0, 0);
            }
            bf16_t* dc = DC + slot * 8192;
#pragma unroll
            for (int dt = 0; dt < 4; ++dt)
#pragma unroll
                for (int vt = 0; vt < 2; ++vt) { const int v = vq * 32 + vt * 16 + fr, d = dt * 16 + 4 * fq; const f32x4 a = acc[dt][vt];
                    *(u32x2*)(dc + v * 64 + d) = (u32x2){cvt_pk_bf16(a[0], a[1]), cvt_pk_bf16(a[2], a[3])}; }
            if (tid < 128) { const int dr = tid >> 6, d = tid & 63; const LAS bf16_t* kr = KS + dr * 64 * PK + d; float sm = 0.f;
#pragma unroll 16
                for (int s2 = 0; s2 < 64; ++s2) sm += bf2f(kr[s2 * PK]);
                const int pos2 = dr == 0 ? cc : (cc < 4 ? 3 - cc : 135 - cc); DN[(size_t)((bh * 2 + dr) * NPOS + pos2) * 64 + d] = sm; }
        }
        __syncthreads();
    }
#undef P3A_LOAD
}
__device__ __forceinline__ void p3b_phase(const Params& p, LAS unsigned char* lds) {
    int tid = threadIdx.x; asm volatile("" : "+v"(tid));
    unsigned char* ws = p.ws;
    unsigned* DC = (unsigned*)(ws + WS_DC); f32x2* DN = (f32x2*)(ws + WS_DN); const f32x2* BG = (const f32x2*)(ws + WS_BG); float* MS = (float*)(ws + WS_MS);
    for (int item = blockIdx.x; item < 256; item += gridDim.x) {
        const int seq = item >> 3, pair = (item & 7) * 512 + tid; const bool nth = pair < 32;
        unsigned* dc = DC + (size_t)seq * NPOS * 4096 + pair; f32x2* dn = DN + (size_t)seq * NPOS * 32 + pair; const f32x2* bg = BG + (size_t)seq * NPOS;
        LAS f32x2* bgl = (LAS f32x2*)lds;
        __syncthreads();
        if (tid < NPOS) bgl[tid] = bg[tid];
        __syncthreads();
        float c0 = 0.f, c1 = 0.f, n0 = 0.f, n1 = 0.f, m = 0.f;
        for (int pb = 0; pb < NPOS; pb += 12) {
            unsigned raw[12]; f32x2 g2[12]; f32x2 dnv[12];
#pragma unroll
            for (int i = 0; i < 12; ++i) { raw[i] = NTL(dc + (size_t)(pb + i) * 4096); g2[i] = bgl[pb + i]; dnv[i] = nth ? dn[(size_t)(pb + i) * 32] : (f32x2){0.f, 0.f}; }
#pragma unroll
            for (int i = 0; i < 12; ++i) { const int pp = pb + i;
                if (pp >= 4) { dc[(size_t)pp * 4096] = cvt_pk_bf16(c0, c1); if (nth) dn[(size_t)pp * 32] = (f32x2){n0, n1}; if (pair == 0) MS[seq * NPOS + pp] = m; }
                const float B = g2[i].x, Gm = g2[i].y, mn = fmaxf(B + m, Gm), a = __expf(B + m - mn), bb = __expf(Gm - mn);
                c0 = a * c0 + bb * bf_lo(raw[i]); c1 = a * c1 + bb * bf_hi(raw[i]); n0 = a * n0 + bb * dnv[i].x; n1 = a * n1 + bb * dnv[i].y; m = mn; }
        }
    }
}
__device__ __forceinline__ void p3c_phase(const Params& p, LAS unsigned char* lds, int, int, int) {
    int tid = threadIdx.x; asm volatile("" : "+v"(tid)); const int lane = tid & 63, wave = __builtin_amdgcn_readfirstlane(tid >> 6);
    unsigned char* ws = p.ws;
    const bf16_t* Qb = (const bf16_t*)(ws + WS_Q); const bf16_t* Kb = (const bf16_t*)(ws + WS_K); const bf16_t* Vb = (const bf16_t*)(ws + WS_V); const bf16_t* SO = (const bf16_t*)(ws + WS_SO);
    const float* G = (const float*)(ws + WS_G); const bf16_t* DC = (const bf16_t*)(ws + WS_DC); const float* DN = (const float*)(ws + WS_DN); const float* MS = (const float*)(ws + WS_MS);
    bf16_t* Y = (bf16_t*)(ws + WS_XN);
    constexpr int PR = 72;
    constexpr int BUFE = 64 * PV + 2 * 64 * PR;
    LAS bf16_t* VS0 = (LAS bf16_t*)lds;
    constexpr int CSE = 128 * PR;
    LAS bf16_t* CS0 = (LAS bf16_t*)(lds + 2 * BUFE * 2);
    LAS float* GA = (LAS float*)(lds + 2 * BUFE * 2 + 2 * CSE * 2);
    LAS float* SSQ = (LAS float*)(lds + 2 * BUFE * 2 + 2 * CSE * 2 + 20480);
    const int fr = lane & 15, fq = lane >> 4;
    const int tw = wave & 3, vh = wave >> 2, t = tw * 16 + fr;
    constexpr int NU = 16 * 128;
    const int G_ = (int)gridDim.x;
#define P3C_VLOAD(U, dst) do { const int c_ = (U) & 127, bh_ = (U) >> 7, b_ = bh_ >> 3, h_ = bh_ & 7, r0_ = b_ * SEQ + c_ * 64; \
        _Pragma("unroll") for (int i = 0; i < 2; ++i) { const int pc = tid + 512 * i; dst[i] = NTL((const u32x4*)(Vb + (size_t)(r0_ + (pc >> 4)) * 1024 + h_ * 128 + (pc & 15) * 8)); } \
        dst[2] = *(const u32x4*)(Kb + (size_t)(r0_ + (tid >> 3)) * 512 + h_ * 64 + (tid & 7) * 8); dst[3] = *(const u32x4*)(Qb + (size_t)(r0_ + (tid >> 3)) * 512 + h_ * 64 + (tid & 7) * 8); \
        { const bf16_t* cs_ = DC + (size_t)((bh_ * 2) * NPOS + 4 + c_) * 8192; dst[4] = NTL((const u32x4*)(cs_ + (size_t)tid * 8)); dst[5] = NTL((const u32x4*)(cs_ + (size_t)(tid + 512) * 8)); } } while (0)
#define P3C_VSTORE(buf, srcv) do { _Pragma("unroll") for (int i = 0; i < 2; ++i) { const int pc = tid + 512 * i; *(LAS u32x4*)(VS0 + (buf) * BUFE + (pc >> 4) * PV + (pc & 15) * 8) = srcv[i]; } \
        *(LAS u32x4*)(VS0 + (buf) * BUFE + 64 * PV + (tid >> 3) * PR + (tid & 7) * 8) = srcv[2]; *(LAS u32x4*)(VS0 + (buf) * BUFE + 64 * PV + 64 * PR + (tid >> 3) * PR + (tid & 7) * 8) = srcv[3]; \
        *(LAS u32x4*)(CS0 + (buf) * CSE + (tid >> 3) * PR + (tid & 7) * 8) = srcv[4]; *(LAS u32x4*)(CS0 + (buf) * CSE + (64 + (tid >> 3)) * PR + (tid & 7) * 8) = srcv[5]; } while (0)
    for (int ubase = blockIdx.x; ubase < NU; ubase += 8 * G_) {
        int nloc = (NU - ubase + G_ - 1) / G_; nloc = nloc > 8 ? 8 : nloc;
        __syncthreads();
        if (wave < nloc) {
            const int u = ubase + wave * G_, c = u & 127, bh = u >> 7, b = bh >> 3, h = bh & 7, row0 = b * SEQ + c * 64;
#pragma unroll
            for (int dir = 0; dir < 2; ++dir) {
                const int pos = dir ? 63 - lane : lane, slot = (bh * 2 + dir) * NPOS + (dir ? 131 - c : 4 + c);
                const float* gp = G + (size_t)(row0 + pos) * 32 + dir * 16 + h; const float li = gp[0], lf = gp[8], mprev = MS[slot], nvv = DN[(size_t)slot * 64 + lane];
                const float bc = wave_incl_sum(lf, lane), a = li - bc;
                const float Mt = fmaxf(mprev, wave_incl_max(a, lane)), mt = bc + Mt;
                LAS float* ga = GA + (wave * 2 + dir) * 320;
                ga[pos] = a; ga[64 + pos] = Mt; ga[128 + pos] = __expf(-mt); ga[192 + pos] = __expf(mprev - Mt); ga[256 + lane] = nvv;
            }
        }
        u32x4 vnext[6];
        { u32x4 v0[6]; P3C_VLOAD(ubase, v0); if (nloc > 1) P3C_VLOAD(ubase + G_, vnext); P3C_VSTORE(0, v0); }
        __syncthreads();
        for (int j = 0; j < nloc; ++j) {
            const int unit = ubase + j * G_;
            const int c = unit & 127, bh = unit >> 7, b = bh >> 3, h = bh & 7, row0 = b * SEQ + c * 64;
            bf16x8 Bq[2], Kf[4][2], Cf[4][2];
            { const LAS bf16_t* KSi = VS0 + (j & 1) * BUFE + 64 * PV; const LAS bf16_t* QSi = KSi + 64 * PR;
#pragma unroll
              for (int ks = 0; ks < 2; ++ks) Bq[ks] = *(const LAS bf16x8*)(QSi + t * PR + ks * 32 + fq * 8);
#pragma unroll
              for (int st = 0; st < 4; ++st) { Kf[st][0] = *(const LAS bf16x8*)(KSi + (st * 16 + fr) * PR + fq * 8); Kf[st][1] = *(const LAS bf16x8*)(KSi + (st * 16 + fr) * PR + 32 + fq * 8); } }
            { const LAS bf16_t* CSi = CS0 + (j & 1) * CSE;
#pragma unroll
              for (int vt = 0; vt < 4; ++vt) { const LAS bf16_t* cp = CSi + (vh * 64 + vt * 16 + fr) * PR + fq * 8; Cf[vt][0] = *(const LAS bf16x8*)cp; Cf[vt][1] = *(const LAS bf16x8*)(cp + 32); } }
            if (j + 1 < nloc) { P3C_VSTORE((j + 1) & 1, vnext); if (j + 2 < nloc) P3C_VLOAD(unit + 2 * G_, vnext); }
            const LAS bf16_t* VS = VS0 + (j & 1) * BUFE;
            f32x4 ST[4];
#pragma unroll
            for (int st = 0; st < 4; ++st) {
                ST[st] = __builtin_amdgcn_mfma_f32_16x16x32_bf16(Kf[st][0], Bq[0], (f32x4){0.f, 0.f, 0.f, 0.f}, 0, 0, 0);
                ST[st] = __builtin_amdgcn_mfma_f32_16x16x32_bf16(Kf[st][1], Bq[1], ST[st], 0, 0, 0); }
            f32x4 hx[4];
#pragma unroll
            for (int vt = 0; vt < 4; ++vt) hx[vt] = (f32x4){0.f, 0.f, 0.f, 0.f};
#pragma unroll
            for (int dir = 0; dir < 2; ++dir) {
                bf16x8 Cn[4][2];
                if (dir == 0) {
                    const bf16_t* Cp = DC + (size_t)((bh * 2 + 1) * NPOS + 131 - c) * 8192;
#pragma unroll
                    for (int vt = 0; vt < 4; ++vt) { const bf16_t* cp = Cp + (vh * 64 + vt * 16 + fr) * 64 + fq * 8; Cn[vt][0] = NTL((const bf16x8*)cp); Cn[vt][1] = NTL((const bf16x8*)(cp + 32)); }
                }
                const LAS float* ga = GA + (j * 2 + dir) * 320;
                const float Mt = ga[64 + t], en = ga[128 + t], wi = ga[192 + t];
                float den = 0.f; f32x4 sw[4];
#pragma unroll
                for (int st = 0; st < 4; ++st) { const f32x4 a4 = *(const LAS f32x4*)(ga + st * 16 + 4 * fq);
#pragma unroll
                    for (int jj = 0; jj < 4; ++jj) { const int s = st * 16 + 4 * fq + jj; const bool ok = dir == 0 ? (s <= t) : (s >= t);
                        const float w = ok ? __expf(a4[jj] - Mt) : 0.f; sw[st][jj] = ST[st][jj] * w; den += sw[st][jj]; } }
                bf16x8 Bsw[2];
#pragma unroll
                for (int kk = 0; kk < 2; ++kk) { u32x4 w; w.x = cvt_pk_bf16(sw[2 * kk][0], sw[2 * kk][1]); w.y = cvt_pk_bf16(sw[2 * kk][2], sw[2 * kk][3]);
                    w.z = cvt_pk_bf16(sw[2 * kk + 1][0], sw[2 * kk + 1][1]); w.w = cvt_pk_bf16(sw[2 * kk + 1][2], sw[2 * kk + 1][3]); Bsw[kk] = __builtin_bit_cast(bf16x8, w); }
                float nq = 0.f;
#pragma unroll
                for (int ks = 0; ks < 2; ++ks) { const LAS float* np = ga + 256 + ks * 32 + fq * 8; const f32x4 n0 = *(const LAS f32x4*)np, n1 = *(const LAS f32x4*)(np + 4);
#pragma unroll
                    for (int i = 0; i < 4; ++i) { nq += bf2f((unsigned short)Bq[ks][i]) * n0[i]; nq += bf2f((unsigned short)Bq[ks][4 + i]) * n1[i]; } }
                den += __shfl_xor(den, 16); den += __shfl_xor(den, 32); nq += __shfl_xor(nq, 16); nq += __shfl_xor(nq, 32);
                const float inv = 1.f / fmaxf(fabsf(wi * nq + den), en);
#pragma unroll
                for (int vt = 0; vt < 4; ++vt) {
                    f32x4 acc = __builtin_amdgcn_mfma_f32_16x16x32_bf16(Cf[vt][0], Bq[0], (f32x4){0.f, 0.f, 0.f, 0.f}, 0, 0, 0);
                    acc = __builtin_amdgcn_mfma_f32_16x16x32_bf16(Cf[vt][1], Bq[1], acc, 0, 0, 0);
                    acc = acc * wi;
#pragma unroll
                    for (int kk = 0; kk < 2; ++kk) acc = __builtin_amdgcn_mfma_f32_16x16x32_bf16(tr_frag(VS, PV, kk * 32, vh * 64 + vt * 16, fr, fq), Bsw[kk], acc, 0, 0, 0);
                    hx[vt] += acc * inv; }
                if (dir == 0) {
#pragma unroll
                    for (int vt = 0; vt < 4; ++vt) { Cf[vt][0] = Cn[vt][0]; Cf[vt][1] = Cn[vt][1]; }
                }
            }
            u32x2 so[4]; f32x4 ng[4];
#pragma unroll
            for (int vt = 0; vt < 4; ++vt) { const int col = h * 128 + vh * 64 + vt * 16 + 4 * fq; so[vt] = NTL((const u32x2*)(SO + (size_t)(row0 + t) * D + col)); ng[vt] = *(const f32x4*)(p.mnorm_g + col); }
            float ss = 0.f;
#pragma unroll
            for (int vt = 0; vt < 4; ++vt) ss += (hx[vt][0] * hx[vt][0] + hx[vt][1] * hx[vt][1]) + (hx[vt][2] * hx[vt][2] + hx[vt][3] * hx[vt][3]);
            ss += __shfl_xor(ss, 16); ss += __shfl_xor(ss, 32);
            LAS float* ssq = SSQ + (j & 1) * 128;
            if (fq == 0) ssq[vh * 64 + t] = ss;
            __syncthreads();
            const float rstd = rsqrtf((ssq[t] + ssq[64 + t]) * (1.f / DV) + EPS);
#pragma unroll
            for (int vt = 0; vt < 4; ++vt) { const int col = h * 128 + vh * 64 + vt * 16 + 4 * fq; const size_t off = (size_t)(row0 + t) * D + col;
                const float y0 = bf_lo(so[vt].x) * hx[vt][0] * rstd * ng[vt][0], y1 = bf_hi(so[vt].x) * hx[vt][1] * rstd * ng[vt][1], y2 = bf_lo(so[vt].y) * hx[vt][2] * rstd * ng[vt][2], y3 = bf_hi(so[vt].y) * hx[vt][3] * rstd * ng[vt][3];
                *(u32x2*)(Y + off) = (u32x2){cvt_pk_bf16(y0, y1), cvt_pk_bf16(y2, y3)}; }
        }
    }
#undef P3C_VLOAD
#undef P3C_VSTORE
}

__device__ __forceinline__ void in_small_tasks(const Params& p, LAS unsigned char* lds) {
    int tid = threadIdx.x; asm volatile("" : "+v"(tid)); const int lane = tid & 63, wave = __builtin_amdgcn_readfirstlane(tid >> 6), fr = lane & 15, fq = lane >> 4;
    unsigned char* ws = p.ws;
    const bf16_t* XN = (const bf16_t*)(ws + WS_XN); const bf16_t* WT = (const bf16_t*)(ws + WS_WIN);
    bf16_t* Kb = (bf16_t*)(ws + WS_K); bf16_t* Vb = (bf16_t*)(ws + WS_V); float* G = (float*)(ws + WS_G);
    constexpr int NGT = MALL / 64, NCT = (2 * CTXL / 64) * 24, PP = 68;
    LAS float* part = (LAS float*)lds;
    for (int tile = blockIdx.x; tile < NGT + NCT; tile += gridDim.x) {
        int r0, n0; const bool gate = tile < NGT;
        if (gate) { r0 = tile * 64; n0 = 3072; } else { const int e = tile - NGT; r0 = MROWS + (e / 24) * 64; n0 = 512 + (e % 24) * 64; }
        const bf16_t* Ap = XN + (size_t)(r0 + fr) * D + wave * 128 + fq * 8; const bf16_t* Bp = WT + (size_t)(n0 + fr) * D + wave * 128 + fq * 8;
        f32x4 acc[4][4];
#pragma unroll
        for (int m = 0; m < 4; ++m)
#pragma unroll
            for (int n = 0; n < 4; ++n) acc[m][n] = (f32x4){0.f, 0.f, 0.f, 0.f};
        if (gate) {
#pragma unroll
            for (int ks = 0; ks < 4; ++ks) { bf16x8 a[4], b[2];
#pragma unroll
                for (int m = 0; m < 4; ++m) a[m] = NTL((const bf16x8*)(Ap + (size_t)m * 16 * D + ks * 32));
#pragma unroll
                for (int n = 0; n < 2; ++n) b[n] = *(const bf16x8*)(Bp + (size_t)n * 16 * D + ks * 32);
#pragma unroll
                for (int m = 0; m < 4; ++m)
#pragma unroll
                    for (int n = 0; n < 2; ++n) acc[m][n] = __builtin_amdgcn_mfma_f32_16x16x32_bf16(b[n], a[m], acc[m][n], 0, 0, 0); }
        } else {
#pragma unroll
            for (int ks = 0; ks < 4; ++ks) { bf16x8 a[4], b[4];
#pragma unroll
                for (int m = 0; m < 4; ++m) a[m] = *(const bf16x8*)(Ap + (size_t)m * 16 * D + ks * 32);
#pragma unroll
                for (int n = 0; n < 4; ++n) b[n] = *(const bf16x8*)(Bp + (size_t)n * 16 * D + ks * 32);
#pragma unroll
                for (int m = 0; m < 4; ++m)
#pragma unroll
                    for (int n = 0; n < 4; ++n) acc[m][n] = __builtin_amdgcn_mfma_f32_16x16x32_bf16(b[n], a[m], acc[m][n], 0, 0, 0); }
        }
        {   LAS float* pw = part + wave * 64 * PP;
#pragma unroll
            for (int m = 0; m < 4; ++m)
#pragma unroll
                for (int n = 0; n < 4; ++n) if (!gate || n < 2) *(LAS f32x4*)(pw + (m * 16 + fr) * PP + n * 16 + 4 * fq) = acc[m][n]; }
        __syncthreads();
        {   const int row = tid >> 3, c8 = (tid & 7) * 8;
            if (!gate || c8 < 32) {
                f32x4 s0 = {0.f, 0.f, 0.f, 0.f}, s1 = s0;
#pragma unroll
                for (int w = 0; w < 8; ++w) { const LAS float* q = part + (w * 64 + row) * PP + c8; s0 += *(const LAS f32x4*)q; s1 += *(const LAS f32x4*)(q + 4); }
                if (gate) {
                    s0 += *(const f32x4*)(p.gate_b + c8); s1 += *(const f32x4*)(p.gate_b + c8 + 4);
                    const bool fgt = (tid & 1) != 0;
#pragma unroll
                    for (int j = 0; j < 4; ++j) {
                        float t0 = 15.f * (1.f - 2.f * __builtin_amdgcn_rcpf(__expf(s0[j] * (2.f / 15.f)) + 1.f)), t1 = 15.f * (1.f - 2.f * __builtin_amdgcn_rcpf(__expf(s1[j] * (2.f / 15.f)) + 1.f));
                        if (fgt) { t0 = fminf(t0, 0.f) - __logf(1.f + __expf(-fabsf(t0))); t1 = fminf(t1, 0.f) - __logf(1.f + __expf(-fabsf(t1))); }
                        s0[j] = t0; s1[j] = t1; }
                    float* gp = G + (size_t)(r0 + row) * 32 + c8; *(f32x4*)gp = s0; *(f32x4*)(gp + 4) = s1;
                } else {
                    const int col = n0 + c8; const u32x4 w = {cvt_pk_bf16(s0[0], s0[1]), cvt_pk_bf16(s0[2], s0[3]), cvt_pk_bf16(s1[0], s1[1]), cvt_pk_bf16(s1[2], s1[3])};
                    if (col < 1024) *(u32x4*)(Kb + (size_t)(r0 + row) * 512 + (col - 512)) = w; else *(u32x4*)(Vb + (size_t)(r0 + row) * 1024 + (col - 1024)) = w;
                }
            }
        }
        __syncthreads();
    }
}

#define XB_TMO      128
#define XB_XCNT(j)  (256  + 64 * (j))
#define XB_XSUB(j)  (1280 + 64 * (j))
#define XB_XGEN(j)  (2304 + 64 * (j))
#define XB_TOP      3328
#define XB_TOPGEN   3392
#define XCD_BAR_WORDS 3456
#define XB_SPIN_CAP (1u << 18)
__device__ __forceinline__ unsigned xb_ld(unsigned* p)              { return __hip_atomic_load(p, __ATOMIC_RELAXED, __HIP_MEMORY_SCOPE_AGENT); }
__device__ __forceinline__ unsigned xb_add(unsigned* p, unsigned v) { return __hip_atomic_fetch_add(p, v, __ATOMIC_RELAXED, __HIP_MEMORY_SCOPE_AGENT); }
__device__ __forceinline__ unsigned xb_xcc_id() { return (unsigned)__builtin_amdgcn_s_getreg((3 << 11) | 20) & 0xFu; }
#define XB_SPIN(cond, bar) do { unsigned _sp = 0; while (cond) { __builtin_amdgcn_s_sleep(1); \
    if ((++_sp & 255u) == 0u) { if (xb_ld(&(bar)[XB_TMO])) break; if (_sp > XB_SPIN_CAP) { atomicAdd(&(bar)[XB_TMO], 1u); break; } } } } while (0)
__device__ __forceinline__ void xcd_barrier_complete(unsigned* bar, unsigned x, unsigned& nloc, unsigned& nx) {
    const unsigned G = gridDim.x * gridDim.y * gridDim.z;
    unsigned sum, cnt, mine, sp = 0u;
    for (;;) {
        sum = 0u; cnt = 0u; mine = 0u;
#pragma unroll
        for (unsigned j = 0; j < 16; ++j) { const unsigned c = xb_ld(&bar[XB_XCNT(j)]); sum += c; cnt += (c > 0u) ? 1u : 0u; mine = (j == x) ? c : mine; }
        if (sum == G) break;
        __builtin_amdgcn_s_sleep(1);
        if ((++sp & 255u) == 0u) { if (xb_ld(&bar[XB_TMO])) break; if (sp > XB_SPIN_CAP) { atomicAdd(&bar[XB_TMO], 1u); break; } }
    }
    nloc = mine > 0u ? mine : 1u; nx = cnt > 0u ? cnt : 1u;
}
__device__ __forceinline__ void xcd_barrier(unsigned* bar, volatile LAS unsigned* st) {
    asm volatile("s_waitcnt vmcnt(0)" ::: "memory");
    __syncthreads();
    if (threadIdx.x == 0) {
        const unsigned x = xb_xcc_id();
        __builtin_amdgcn_s_waitcnt(0);
        unsigned nloc = st[0], nx = st[1];
        if (nloc == 0u) { xcd_barrier_complete(bar, x, nloc, nx); st[0] = nloc; st[1] = nx; }
        const unsigned old = xb_add(&bar[XB_XSUB(x)], 1u);
        const unsigned gen = old / nloc;
        if (old + 1u == (gen + 1u) * nloc) {
            __builtin_amdgcn_fence(__ATOMIC_RELEASE, "agent");
            asm volatile("s_waitcnt vmcnt(0)" ::: "memory");
            const unsigned og = xb_add(&bar[XB_TOP], 1u);
            const unsigned tg = og / nx;
            if (og + 1u == (tg + 1u) * nx) xb_add(&bar[XB_TOPGEN], 1u);
            else XB_SPIN(xb_ld(&bar[XB_TOPGEN]) == tg, bar);
            __builtin_amdgcn_fence(__ATOMIC_ACQUIRE, "agent");
            xb_add(&bar[XB_XGEN(x)], 1u);
            asm volatile("s_waitcnt vmcnt(0)" ::: "memory");
        } else {
            XB_SPIN(xb_ld(&bar[XB_XGEN(x)]) == gen, bar);
            __builtin_amdgcn_fence(__ATOMIC_ACQUIRE, "agent");
            asm volatile("s_waitcnt vmcnt(0)" ::: "memory");
        }
    }
    __syncthreads();
}
#define GSYNC() do { const Params pb_ = load_params(); xcd_barrier((unsigned*)(pb_.ws + WS_BAR), (volatile LAS unsigned*)(lds + LDS_BYTES - 16)); } while (0)
__device__ __forceinline__ Params load_params() {
#if defined(__HIP_DEVICE_COMPILE__)
    const __attribute__((address_space(4))) Params* kp = (const __attribute__((address_space(4))) Params*)__builtin_amdgcn_kernarg_segment_ptr();
    asm volatile("" : "+s"(kp));
    return *kp;
#else
    return Params{};
#endif
}
template <int L> __device__ __forceinline__ void mlp_layer(LAS unsigned char* lds, cg::grid_group& grid) {
    const bool fused = gridDim.x == 256;
    if (!fused) {
        { const Params p = load_params(); norm_phase(p, p.out, p.norm2_g + L * 1024, L, 3, false, 0, 0); }
        GSYNC();
    }
    {
        const Params p = load_params();
        pg8::Gemm g{(const bf16_t*)(p.ws + WS_XN), (const bf16_t*)(p.ws + WS_W1) + (size_t)L * FF * D}; pg8::StaticOrder S; S.init(MROWS, FF, gridDim.x, blockIdx.x);
        pg8::EpiRelu2 E{(bf16_t*)(p.ws + WS_H)};
        pg8::gemm_phase<pg8::EpiRelu2, pg8::StaticOrder, true, D, D, D, 0>(lds, g, S, E);
    }
    GSYNC();
    {
        const Params p = load_params();
        pg8::Gemm g{(const bf16_t*)(p.ws + WS_H), (const bf16_t*)(p.ws + WS_W2) + (size_t)L * D * FF}; pg8::StaticOrder S; S.init(MROWS, D, gridDim.x, blockIdx.x);
        const float* g2 = (const float*)(p.ws + WS_MOD) + (size_t)L * 3 * 6144 + 5 * 1024;
        if (fused) {
            const float* M1 = (const float*)(p.ws + WS_MOD) + 3 * 6144;
            float* xch = (float*)(p.ws + WS_XCH); unsigned* pc = (unsigned*)(p.ws + WS_PCNT);
            if constexpr (L == 0) {
                pg8::EpiPoolFused E{p.out, g2, 6144, xch + (size_t)1 * MROWS * 4, pc + 1 * 4096, xch + (size_t)2 * MROWS * 4, pc + 2 * 4096,
                    p.norm1_g + 1024, M1 + 1024, M1, p.norm2_g + 1024, M1 + 4 * 1024, M1 + 3 * 1024, 6144, (bf16_t*)(p.ws + WS_XN), (const bf16_t*)(p.ws + WS_POOLG)};
                pg8::gemm_phase<pg8::EpiPoolFused, pg8::StaticOrder, false, FF, FF, FF, 0>(lds, g, S, E);
            } else {
                pg8::EpiNorm<0> E{p.out, p.out, g2, 6144, xch + (size_t)3 * MROWS * 4, pc + 3 * 4096, p.final_g, nullptr, nullptr, 0, nullptr, nullptr};
                pg8::gemm_phase<pg8::EpiNorm<0>, pg8::StaticOrder, false, FF, FF, FF, 0>(lds, g, S, E);
            }
        } else {
            pg8::EpiRes E{p.out, p.out, g2, 6144};
            pg8::gemm_phase<pg8::EpiRes, pg8::StaticOrder, false, FF, FF, FF, 0>(lds, g, S, E);
        }
    }
    if (!(L == 1 && fused)) GSYNC();
}
__global__ void __launch_bounds__(512, 2) fwd_megakernel(Params p_unused) {
    extern __shared__ __attribute__((aligned(16))) unsigned char lds_raw[];
    cg::grid_group grid = cg::this_grid();
    LAS unsigned char* lds = (LAS unsigned char*)lds_raw;
    {   const Params p = load_params();
        if (__builtin_expect(p.ws == nullptr, 0)) grid.sync();
        volatile LAS unsigned* st = (volatile LAS unsigned*)(lds + LDS_BYTES - 16);
        if (threadIdx.x < 4) st[threadIdx.x] = 0u;
        __syncthreads();
        if (threadIdx.x == 0) (void)xb_add(&((unsigned*)(p.ws + WS_BAR))[XB_XCNT(xb_xcc_id())], 1u);
    }
    { const Params p = load_params(); p0_phase(p, lds, 0, 0, 0); }
    {
        const Params p = load_params(); unsigned* mc = (unsigned*)(p.ws + WS_BAR) + 4000;
        if (threadIdx.x < 64) { unsigned spins = 0;
            while ((unsigned)__builtin_amdgcn_readfirstlane(__hip_atomic_load(mc, __ATOMIC_RELAXED, __HIP_MEMORY_SCOPE_AGENT)) < 32u) { __builtin_amdgcn_s_sleep(2); if (++spins > (1u << 20)) break; }
            __builtin_amdgcn_fence(__ATOMIC_ACQUIRE, "agent"); asm volatile("s_waitcnt vmcnt(0)" ::: "memory"); }
        __syncthreads();
        norm_phase(p, p.x, p.norm1_g, 0, 0, true, 0, 0);
    }
    GSYNC();
    { const Params p = load_params();
      if (blockIdx.x == 0) { const float* MODp = (const float*)(p.ws + WS_MOD); float* GS = (float*)(p.ws + WS_GS);
          for (int i = threadIdx.x; i < 2048; i += 512) GS[i] = MODp[(size_t)(3 + (i >> 10)) * 6144 + 2 * 1024 + (i & 1023)] * p.pool_scale[i & 1023]; }
      {
          const float* MODp = (const float*)(p.ws + WS_MOD); const bf16_t* PT = (const bf16_t*)(p.ws + WS_POOL); bf16_t* PG = (bf16_t*)(p.ws + WS_POOLG);
          for (int i = blockIdx.x * 512 + threadIdx.x; i < 2 * 1024 * 256; i += gridDim.x * 512) { const int b = i >> 18, n = (i >> 8) & 1023;
              PG[i] = f2bf(bf2f(PT[i & 262143]) * MODp[(size_t)(3 + b) * 6144 + 2 * 1024 + n] * p.pool_scale[n]); } } }
    {
        const Params p = load_params(); unsigned char* ws = p.ws;
        pg8::Gemm g{(const bf16_t*)(ws + WS_XN), (const bf16_t*)(ws + WS_WIN)}; pg8::InOrder S; S.init(gridDim.x, blockIdx.x);
        pg8::EpiIn E{(bf16_t*)(ws + WS_Q), (bf16_t*)(ws + WS_K), (bf16_t*)(ws + WS_V), (bf16_t*)(ws + WS_SO), (float*)(ws + WS_G), p.gate_b};
        pg8::gemm_phase<pg8::EpiIn, pg8::InOrder, true, D, D, D, 0>(lds, g, S, E);
    }
    { const Params p = load_params(); in_small_tasks(p, lds); }
    GSYNC();
    { const Params p = load_params(); p3a_phase(p, lds, 0, 0, 0); }
    GSYNC();
    { const Params p = load_params(); p3b_phase(p, lds); }
    GSYNC();
    { const Params p = load_params(); p3c_phase(p, lds, 0, 0, 0); }
    GSYNC();
    {
        const Params p = load_params();
        pg8::Gemm g{(const bf16_t*)(p.ws + WS_XN), (const bf16_t*)(p.ws + WS_WOUT)}; pg8::StaticOrder S; S.init(MROWS, D, gridDim.x, blockIdx.x);
        const float* M0 = (const float*)(p.ws + WS_MOD);
        if (gridDim.x == 256) {
            pg8::EpiNorm<1> E{p.x, p.out, M0 + 2 * 1024, 6144, (float*)(p.ws + WS_XCH), (unsigned*)(p.ws + WS_PCNT), p.norm2_g, M0 + 4 * 1024, M0 + 3 * 1024, 6144, (bf16_t*)(p.ws + WS_XN), nullptr};
            pg8::gemm_phase<pg8::EpiNorm<1>, pg8::StaticOrder, false, D, D, D, 0>(lds, g, S, E);
        } else {
            pg8::EpiRes E{p.x, p.out, M0 + 2 * 1024, 6144};
            pg8::gemm_phase<pg8::EpiRes, pg8::StaticOrder, false, D, D, D, 0>(lds, g, S, E);
        }
    }
    GSYNC();
    mlp_layer<0>(lds, grid);
    if (gridDim.x != 256) {
        { const Params p = load_params(); pool_phase(p, lds, nullptr); }
        GSYNC();
    }
    if (gridDim.x != 256) {
        {
            const Params p = load_params();
            pg8::Gemm g{(const bf16_t*)(p.ws + WS_XN), (const bf16_t*)(p.ws + WS_POOL)}; pg8::StaticOrder S; S.init(MROWS, D, gridDim.x, blockIdx.x);
            pg8::EpiRes E{p.out, p.out, (const float*)(p.ws + WS_GS), 1024};
            pg8::gemm_phase<pg8::EpiRes, pg8::StaticOrder, false, D, 256, 256, 256>(lds, g, S, E);
        }
        GSYNC();
    }
    mlp_layer<1>(lds, grid);
    if (gridDim.x != 256) { const Params p = load_params(); final_norm_phase(p, 0, 0); }
}

extern "C" void kernel_launch(void* const* d_in, const int* in_sizes, int n_in, void* d_out, int out_size, void* d_ws, size_t ws_size, hipStream_t stream) {
    static int grid = 0;
    if (grid == 0) {
        int dev = 0, cus = 0, per_cu = 0;
        (void)hipGetDevice(&dev);
        (void)hipDeviceGetAttribute(&cus, hipDeviceAttributeMultiprocessorCount, dev);
        if (hipFuncSetAttribute((const void*)fwd_megakernel, hipFuncAttributeMaxDynamicSharedMemorySize, LDS_BYTES) != hipSuccess) fprintf(stderr, "kernel_launch: hipFuncSetAttribute failed\n");
        if (hipOccupancyMaxActiveBlocksPerMultiprocessor(&per_cu, (const void*)fwd_megakernel, 512, LDS_BYTES) != hipSuccess || per_cu < 1) { fprintf(stderr, "kernel_launch: occupancy query gave %d\n", per_cu); per_cu = 1; }
        (void)hipGetLastError();
        if (cus <= 0) cus = 256;
        grid = cus * per_cu;
    }
    Params p{};
    p.x = (const float*)d_in[0]; p.c = (const float*)d_in[1]; p.ctx = (const float*)d_in[2]; p.c_ctx = (const float*)d_in[3];
    p.ada_w = (const float*)d_in[4]; p.ada_b = (const float*)d_in[5]; p.norm1_g = (const float*)d_in[6]; p.norm2_g = (const float*)d_in[7];
    p.w_in = (const float*)d_in[8]; p.gate_b = (const float*)d_in[9]; p.mnorm_g = (const float*)d_in[10]; p.w_out = (const float*)d_in[11];
    p.pool_w = (const float*)d_in[12]; p.pool_scale = (const float*)d_in[13]; p.w1 = (const float*)d_in[14]; p.w2 = (const float*)d_in[15]; p.final_g = (const float*)d_in[16];
    p.out = (float*)d_out; p.ws = (unsigned char*)d_ws;
    (void)hipMemsetAsync((char*)d_ws + WS_BAR, 0, CTL_BYTES, stream);
    void* args[] = {&p};
    hipError_t e = hipLaunchCooperativeKernel((const void*)fwd_megakernel, dim3(grid), dim3(512), args, LDS_BYTES, stream);
    if (e != hipSuccess) fprintf(stderr, "cooperative launch failed: %s (grid %d)\n", hipGetErrorString(e), grid);
}
```
